# Optimizing an MI355X kernel written in HIP

```python
import math
import jax, jax.numpy as jnp
from jax import lax
import numpy as np

D_MODEL = 1024
BATCH = 4
SEQ = 8192
DEPTH = 4

N_MIXERS = 3
GRID_W = 64
Q_BLOCK = 128
EPS = 1e-6
D_FF = 2816
FFN_RES = 0.5

DIFF_HEAD_DIM = 64
DIFF_HEADS = D_MODEL // (2 * DIFF_HEAD_DIM)
ROPE_THETA = 500000.0
ROPE_DIMS = DIFF_HEAD_DIM // 4

NA_HEAD_DIM = 64
NA_HEADS = D_MODEL // NA_HEAD_DIM
NA_WIN_H = 8
NA_WIN_W = 16

GQA_HEAD_DIM = 64
GQA_Q_HEADS = D_MODEL // GQA_HEAD_DIM
GQA_KV_HEADS = GQA_Q_HEADS // 4
AXIAL_THETA = 10000.0

N_A = len(range(0, DEPTH, N_MIXERS))
N_B = len(range(1, DEPTH, N_MIXERS))
N_C = len(range(2, DEPTH, N_MIXERS))

kernel_name = 'hybrid_diff_na_gqa_macaron_encoder'


def _rmsnorm(x, g):
    xf = x.astype(jnp.float32)
    y = xf * lax.rsqrt(jnp.mean(xf * xf, axis=-1, keepdims=True) + EPS)
    return (y * g.astype(jnp.float32)).astype(x.dtype)


def _swiglu(x, wg, wu, wd):
    return (jax.nn.silu(x @ wg) * (x @ wu)) @ wd


def _rope_angles(pos, dims, theta):
    inv = theta ** (-jnp.arange(0, dims, 2, dtype=jnp.float32) / dims)
    return pos[:, None] * inv[None, :]


def _rotate(x, ang):
    m = ang.shape[1]
    ang = ang.reshape((1, ang.shape[0]) + (1,) * (x.ndim - 3) + (m,))
    cos = jnp.cos(ang).astype(x.dtype)
    sin = jnp.sin(ang).astype(x.dtype)
    x1, x2 = x[..., :m], x[..., m:]
    return jnp.concatenate([x1 * cos - x2 * sin, x2 * cos + x1 * sin], axis=-1)


def _to_blocks(q):
    b, s = q.shape[:2]
    return jnp.moveaxis(q.reshape((b, s // Q_BLOCK, Q_BLOCK) + q.shape[2:]), 1, 0)


def _from_blocks(o):
    o = jnp.moveaxis(o, 0, 1)
    return o.reshape((o.shape[0], o.shape[1] * o.shape[2]) + o.shape[3:])


def _diff_attention(h, w_in, w_out, lam_vecs, subln_g, layer_idx):
    b, s, _ = h.shape
    nh, dh = DIFF_HEADS, DIFF_HEAD_DIM
    q, k, v = jnp.split(h @ w_in, 3, axis=-1)
    q = q.reshape(b, s, nh, 2, dh)
    k = k.reshape(b, s, nh, 2, dh)
    v = v.reshape(b, s, nh, 2 * dh)
    ang = _rope_angles(jnp.arange(s, dtype=jnp.float32), ROPE_DIMS, ROPE_THETA)
    q = jnp.concatenate([_rotate(q[..., :ROPE_DIMS], ang), q[..., ROPE_DIMS:]], axis=-1)
    k = jnp.concatenate([_rotate(k[..., :ROPE_DIMS], ang), k[..., ROPE_DIMS:]], axis=-1)
    lam_init = 0.8 - 0.6 * math.exp(-0.3 * layer_idx)
    lv = lam_vecs.astype(jnp.float32)
    lam = jnp.exp(jnp.sum(lv[0] * lv[1])) - jnp.exp(jnp.sum(lv[2] * lv[3])) + lam_init
    scale = dh ** -0.5

    def block(qb):
        sc = jnp.einsum('bqhcd,bshcd->bhcqs', qb, k).astype(jnp.float32) * scale
        p = jax.nn.softmax(sc, axis=-1)
        a = (p[:, :, 0] - lam * p[:, :, 1]).astype(v.dtype)
        return jnp.einsum('bhqs,bshe->bqhe', a, v)

    o = _from_blocks(lax.map(block, _to_blocks(q)))
    o = _rmsnorm(o, subln_g) * (1.0 - lam_init)
    return o.reshape(b, s, nh * 2 * dh) @ w_out


def _neighborhood_attention(h, w_in, w_out, rpb):
    b, s, _ = h.shape
    nh, dh = NA_HEADS, NA_HEAD_DIM
    rows = s // GRID_W
    kh = min(NA_WIN_H, rows)
    kw = NA_WIN_W
    q, k, v = jnp.split(h @ w_in, 3, axis=-1)
    q = q.reshape(b, rows, GRID_W, nh, dh)
    k = k.reshape(b, rows, GRID_W, nh, dh)
    v = v.reshape(b, rows, GRID_W, nh, dh)
    cols = jnp.arange(GRID_W)
    col_start = jnp.clip(cols - kw // 2, 0, GRID_W - kw)
    col_idx = col_start[:, None] + jnp.arange(kw)[None, :]
    dc = col_idx - cols[:, None] + (NA_WIN_W - 1)
    scale = dh ** -0.5

    def row_step(r):
        r0 = jnp.clip(r - kh // 2, 0, rows - kh)
        dr = r0 + jnp.arange(kh) - r + (NA_WIN_H - 1)
        k_band = lax.dynamic_slice_in_dim(k, r0, kh, axis=1)
        v_band = lax.dynamic_slice_in_dim(v, r0, kh, axis=1)
        k_win = k_band[:, :, col_idx]
        v_win = v_band[:, :, col_idx]
        q_row = lax.dynamic_index_in_dim(q, r, axis=1, keepdims=False)
        bias = rpb[:, dr[None, :, None], dc[:, None, :]]
        sc = jnp.einsum('bqhd,brqjhd->bhqrj', q_row, k_win).astype(jnp.float32) * scale
        sc = sc + bias.astype(jnp.float32)[None]
        p = jax.nn.softmax(sc.reshape(b, nh, GRID_W, kh * kw), axis=-1)
        p = p.reshape(sc.shape).astype(v.dtype)
        return jnp.einsum('bhqrj,brqjhd->bqhd', p, v_win)

    o = lax.map(row_step, jnp.arange(rows))
    o = jnp.moveaxis(o, 0, 1).reshape(b, s, nh * dh)
    return o @ w_out


def _gqa_axial(h, w_in, w_out, qk_g):
    b, s, _ = h.shape
    nq, nkv, dh = GQA_Q_HEADS, GQA_KV_HEADS, GQA_HEAD_DIM
    grp = nq // nkv
    qkv = h @ w_in
    q = qkv[..., :nq * dh].reshape(b, s, nkv, grp, dh)
    k = qkv[..., nq * dh:(nq + nkv) * dh].reshape(b, s, nkv, dh)
    v = qkv[..., (nq + nkv) * dh:].reshape(b, s, nkv, dh)
    q = _rmsnorm(q, qk_g[0])
    k = _rmsnorm(k, qk_g[1])
    t = jnp.arange(s)
    half = dh // 2
    ang_r = _rope_angles((t // GRID_W).astype(jnp.float32), half, AXIAL_THETA)
    ang_c = _rope_angles((t % GRID_W).astype(jnp.float32), half, AXIAL_THETA)
    q = jnp.concatenate([_rotate(q[..., :half], ang_r), _rotate(q[..., half:], ang_c)], axis=-1)
    k = jnp.concatenate([_rotate(k[..., :half], ang_r), _rotate(k[..., half:], ang_c)], axis=-1)
    scale = dh ** -0.5

    def block(qb):
        sc = jnp.einsum('bqkgd,bskd->bkgqs', qb, k).astype(jnp.float32) * scale
        p = jax.nn.softmax(sc, axis=-1).astype(v.dtype)
        return jnp.einsum('bkgqs,bskd->bqkgd', p, v)

    o = _from_blocks(lax.map(block, _to_blocks(q)))
    return o.reshape(b, s, nq * dh) @ w_out


def setup_inputs(seed: int = 0) -> dict:
    key = jax.random.key(seed)
    ks = jax.random.split(key, 20)

    def w(k, shape, fan_in):
        return jax.random.normal(k, shape, jnp.float32) * fan_in ** -0.5

    def gain(k, shape):
        return 1.0 + 0.05 * jax.random.normal(k, shape, jnp.float32)

    diff_w = DIFF_HEADS * 2 * DIFF_HEAD_DIM
    na_w = NA_HEADS * NA_HEAD_DIM
    gqa_q = GQA_Q_HEADS * GQA_HEAD_DIM
    gqa_in = (GQA_Q_HEADS + 2 * GQA_KV_HEADS) * GQA_HEAD_DIM
    return {
        'x': jax.random.normal(ks[0], (BATCH, SEQ, D_MODEL), jnp.float32),
        'norm_g': gain(ks[1], (DEPTH, 6, D_MODEL)),
        'ffn1_wg': w(ks[2], (DEPTH, D_MODEL, D_FF), D_MODEL),
        'ffn1_wu': w(ks[3], (DEPTH, D_MODEL, D_FF), D_MODEL),
        'ffn1_wd': w(ks[4], (DEPTH, D_FF, D_MODEL), D_FF),
        'ffn2_wg': w(ks[5], (DEPTH, D_MODEL, D_FF), D_MODEL),
        'ffn2_wu': w(ks[6], (DEPTH, D_MODEL, D_FF), D_MODEL),
        'ffn2_wd': w(ks[7], (DEPTH, D_FF, D_MODEL), D_FF),
        'diff_w_in': w(ks[8], (N_A, D_MODEL, 3 * diff_w), D_MODEL),
        'diff_w_out': w(ks[9], (N_A, diff_w, D_MODEL), diff_w),
        'diff_lambda': 0.1 * jax.random.normal(ks[10], (N_A, 4, DIFF_HEAD_DIM), jnp.float32),
        'diff_subln': gain(ks[11], (N_A, 2 * DIFF_HEAD_DIM)),
        'na_w_in': w(ks[12], (N_B, D_MODEL, 3 * na_w), D_MODEL),
        'na_w_out': w(ks[13], (N_B, na_w, D_MODEL), na_w),
        'na_rpb': 0.1 * jax.random.normal(ks[14], (N_B, NA_HEADS, 2 * NA_WIN_H - 1, 2 * NA_WIN_W - 1), jnp.float32),
        'gqa_w_in': w(ks[15], (N_C, D_MODEL, gqa_in), D_MODEL),
        'gqa_w_out': w(ks[16], (N_C, gqa_q, D_MODEL), gqa_q),
        'gqa_qk_norm': gain(ks[17], (N_C, 2, GQA_HEAD_DIM)),
    }


def reference(x, norm_g, ffn1_wg, ffn1_wu, ffn1_wd, ffn2_wg, ffn2_wu, ffn2_wd,
              diff_w_in, diff_w_out, diff_lambda, diff_subln,
              na_w_in, na_w_out, na_rpb,
              gqa_w_in, gqa_w_out, gqa_qk_norm):
    h = x
    for i in range(DEPTH):
        g = norm_g[i]
        h = h + FFN_RES * _rmsnorm(_swiglu(_rmsnorm(h, g[0]), ffn1_wg[i], ffn1_wu[i], ffn1_wd[i]), g[1])
        u = _rmsnorm(h, g[2])
        kind, j = i % N_MIXERS, i // N_MIXERS
        if kind == 0:
            m = _diff_attention(u, diff_w_in[j], diff_w_out[j], diff_lambda[j], diff_subln[j], i)
        elif kind == 1:
            m = _neighborhood_attention(u, na_w_in[j], na_w_out[j], na_rpb[j])
        else:
            m = _gqa_axial(u, gqa_w_in[j], gqa_w_out[j], gqa_qk_norm[j])
        h = h + _rmsnorm(m, g[3])
        h = h + FFN_RES * _rmsnorm(_swiglu(_rmsnorm(h, g[4]), ffn2_wg[i], ffn2_wu[i], ffn2_wd[i]), g[5])
    return h
```

```cpp
#include <hip/hip_runtime.h>
#include <hip/hip_cooperative_groups.h>
#include <cstdio>
#include <cstdint>
#include <cmath>
namespace cg = cooperative_groups;
namespace pg8 {
#define PG8_LAS __attribute__((address_space(3)))
typedef unsigned short bf16_t;
typedef short bf16x8 __attribute__((ext_vector_type(8)));
typedef float f32x4 __attribute__((ext_vector_type(4)));
typedef unsigned u32x4 __attribute__((ext_vector_type(4)));
constexpr int BM = 256, BK = 64, HALF = 128, HTB = HALF * BK * 2  , STAGE_BYTES = 8 * HTB, NXCD = 8, WGM = 8;

__host__ __device__ __forceinline__ int lds_byte(int r, int c) { const int st = (r >> 4) * 2 + (c >> 5), rr = r & 15, cc = c & 31, ob = rr * 64 + cc * 2; return st * 1024 + (ob ^ (((ob >> 9) & 1) << 5)); }
__host__ __device__ __forceinline__ void stage_rc(int b, int& R, int& C) { const int st = b / 1024, sb = b % 1024, swz = sb ^ (((sb >> 9) & 1) << 5); R = (st >> 1) * 16 + swz / 64; C = (st & 1) * 32 + (swz % 64) / 2; }
__host__ __device__ __forceinline__ int perm32(int rho) { const int n = rho >> 4, i = rho & 15; return 8 * (i >> 2) + 4 * n + (i & 3); }

struct Unit { int pm, pn; };
struct Gemm { const bf16_t* A; const bf16_t* Bt; int M, N, K; };

struct StaticOrder {
    int nM, nN, nwg, G, c;
    __host__ __device__ void init(int M, int N, int G_, int c_) { nM = M / BM; nN = N / BM; nwg = nM * nN; G = G_; c = c_; }
    __host__ __device__ bool next(int i, Unit& u) const {
        const long L = (long)i * G + c; if (L >= nwg) return false;
        int wgid = (int)L; { const int q = nwg / NXCD, r = nwg % NXCD, xcd = wgid % NXCD, off = wgid / NXCD; wgid = (xcd < r ? xcd * (q + 1) : r * (q + 1) + (xcd - r) * q) + off; }
        const int nig = WGM * nN, gid = wgid / nig, fm = gid * WGM, gsz = (nM - fm) < WGM ? (nM - fm) : WGM;
        u.pm = fm + ((wgid % nig) % gsz); u.pn = (wgid % nig) / gsz; return true;
    }
    __device__ __forceinline__ void a_ready(const Unit&) const {}
    __device__ __forceinline__ void done(const Unit&) const {}
};

__device__ __forceinline__ unsigned cvt_pk_bf16(float lo, float hi) { unsigned r; asm volatile("v_cvt_pk_bf16_f32 %0, %1, %2" : "=v"(r) : "v"(lo), "v"(hi)); return r; }
typedef float f32x2 __attribute__((ext_vector_type(2)));
struct EpiStore {
    static constexpr bool PERM = true, AFTER_DRAIN = false;
    bf16_t* O; int ldc;
    __device__ __forceinline__ void operator()(const f32x4 (&acc)[2][2][4][2], const Unit& u, int wr, int wc, int fr, int fq) const {
        const int row0 = u.pm * BM + wr * 64 + fr; const int col0 = u.pn * BM + wc * 32 + 8 * fq;
#pragma unroll
        for (int ai = 0; ai < 2; ++ai)
#pragma unroll
            for (int m = 0; m < 4; ++m) { bf16_t* rowp = O + (size_t)(row0 + ai * HALF + m * 16) * ldc + col0;
#pragma unroll
                for (int bj = 0; bj < 2; ++bj) { const f32x4 v0 = acc[ai][bj][m][0], v1 = acc[ai][bj][m][1];
                    u32x4 w; w.x = cvt_pk_bf16(v0[0], v0[1]); w.y = cvt_pk_bf16(v0[2], v0[3]); w.z = cvt_pk_bf16(v1[0], v1[1]); w.w = cvt_pk_bf16(v1[2], v1[3]);
                    *(u32x4*)(rowp + bj * HALF) = w; } }
    }
};
__device__ __forceinline__ float silu_mul(float g, float u) { const float e = __builtin_amdgcn_exp2f(g * -1.4426950408889634f); return g * __builtin_amdgcn_rcpf(1.0f + e) * u; }
struct EpiSwiglu {
    static constexpr bool PERM = true, AFTER_DRAIN = false;
    bf16_t* O; int ldc;
    __device__ __forceinline__ void operator()(const f32x4 (&acc)[2][2][4][2], const Unit& u, int wr, int wc, int fr, int fq) const {
        const int row0 = u.pm * BM + wr * 64 + fr; const int col0 = u.pn * HALF + wc * 32 + 8 * fq;
#pragma unroll
        for (int ai = 0; ai < 2; ++ai)
#pragma unroll
            for (int m = 0; m < 4; ++m) { bf16_t* rowp = O + (size_t)(row0 + ai * HALF + m * 16) * ldc + col0;
                const f32x4 g0 = acc[ai][0][m][0], g1 = acc[ai][0][m][1], u0 = acc[ai][1][m][0], u1 = acc[ai][1][m][1];
                u32x4 w; w.x = cvt_pk_bf16(silu_mul(g0[0], u0[0]), silu_mul(g0[1], u0[1])); w.y = cvt_pk_bf16(silu_mul(g0[2], u0[2]), silu_mul(g0[3], u0[3]));
                w.z = cvt_pk_bf16(silu_mul(g1[0], u1[0]), silu_mul(g1[1], u1[1])); w.w = cvt_pk_bf16(silu_mul(g1[2], u1[2]), silu_mul(g1[3], u1[3]));
                *(u32x4*)rowp = w; }
    }
};
template <class Epi, class Sched, bool ALIGN_EPI = false, bool SP2 = false>
__device__ __forceinline__ void gemm_phase(PG8_LAS unsigned char* lds, const Gemm g, const Sched& S, const Epi& E) {
    int tid_l = threadIdx.x; asm volatile("" : "+v"(tid_l));
    const int tid = tid_l, wid = __builtin_amdgcn_readfirstlane(tid >> 6), lane = tid & 63, wr = wid >> 2, wc = wid & 3, fr = lane & 15, fq = lane >> 4;
    const int K = g.K, nt = K / BK;
    unsigned voffA[2], voffB[2];
#pragma unroll
    for (int i = 0; i < 2; ++i) { int R, C; stage_rc(tid * 16 + i * 8192, R, C); const int Rb = Epi::PERM ? ((R & ~31) + perm32(R & 31)) : R;
        voffA[i] = (unsigned)(R * K + C) * 2u; voffB[i] = (unsigned)(Rb * K + C) * 2u; }
    const size_t kstep = (size_t)(BK * 2);
    const size_t hstep = (size_t)HALF * K * 2;
    const size_t tstep = 2 * hstep;
    const unsigned ldsw = (unsigned)wid * 1024u;
    const int aoff = lds_byte(wr * 64 + fr, fq * 8), boff = lds_byte(wc * 32 + fr, fq * 8);
#define PG8_SA(b, h) (((b) * 2 + (h)) * HTB)
#define PG8_SB(b, h) ((4 + (b) * 2 + (h)) * HTB)
#define PG8_STAGE(bufoff, gbase, voff) do { _Pragma("unroll") for (int _i = 0; _i < 2; ++_i) \
        __builtin_amdgcn_global_load_lds((const unsigned*)((const char*)(gbase) + (voff)[_i]), (PG8_LAS unsigned*)(lds + (bufoff) + ldsw + _i * 8192), 16, 0, 0); } while (0)
#define PG8_LDA(dst, b, h) do { _Pragma("unroll") for (int m = 0; m < 4; ++m) _Pragma("unroll") for (int k = 0; k < 2; ++k) dst[m][k] = *(const PG8_LAS bf16x8*)(lds + PG8_SA(b, h) + aoff + m * 2048 + k * 1024); } while (0)
#define PG8_LDB(dst, b, h) do { _Pragma("unroll") for (int n = 0; n < 2; ++n) _Pragma("unroll") for (int k = 0; k < 2; ++k) dst[n][k] = *(const PG8_LAS bf16x8*)(lds + PG8_SB(b, h) + boff + n * 2048 + k * 1024); } while (0)
#define PG8_MMA(ai, bj, At, Bt) do { __builtin_amdgcn_s_setprio(1); _Pragma("unroll") for (int m = 0; m < 4; ++m) _Pragma("unroll") for (int n = 0; n < 2; ++n) _Pragma("unroll") for (int k = 0; k < 2; ++k) \
        acc[ai][bj][m][n] = __builtin_amdgcn_mfma_f32_16x16x32_bf16(Bt[n][k], At[m][k], acc[ai][bj][m][n], 0, 0, 0); __builtin_amdgcn_s_setprio(0); } while (0)
#define PG8_WAIT_V(n) asm volatile("s_waitcnt vmcnt(" #n ")" ::: "memory")
#define PG8_WAIT_L(n) asm volatile("s_waitcnt lgkmcnt(" #n ")" ::: "memory")
#define PG8_BAR __builtin_amdgcn_s_barrier()
#define PG8_SCHED __builtin_amdgcn_sched_barrier(0)
    Unit cur, nxt; int ui = 0;
    if (!S.next(0, cur)) return;
    f32x4 acc[2][2][4][2];
#pragma unroll
    for (int a = 0; a < 2; ++a)
#pragma unroll
        for (int b = 0; b < 2; ++b)
#pragma unroll
            for (int m = 0; m < 4; ++m)
#pragma unroll
                for (int n = 0; n < 2; ++n) acc[a][b][m][n] = (f32x4){0.f, 0.f, 0.f, 0.f};
    bf16x8 At[4][2], B0[2][2], B1[2][2];
    const char* cA = (const char*)g.A + (size_t)cur.pm * tstep; const char* cB = (const char*)g.Bt + (size_t)cur.pn * tstep;
    S.a_ready(cur);
    if constexpr (SP2) {
        PG8_STAGE(PG8_SB(0, 0), cB, voffB); PG8_STAGE(PG8_SB(0, 1), cB + hstep, voffB); PG8_STAGE(PG8_SA(0, 0), cA, voffA); PG8_STAGE(PG8_SA(0, 1), cA + hstep, voffA);
        if (wr == 1) PG8_BAR;
        PG8_WAIT_V(2); PG8_BAR;
        PG8_STAGE(PG8_SB(1, 0), cB + kstep, voffB); PG8_STAGE(PG8_SA(1, 0), cA + kstep, voffA); PG8_STAGE(PG8_SB(1, 1), cB + hstep + kstep, voffB);
        PG8_WAIT_V(6); PG8_BAR;
    } else {
        PG8_STAGE(PG8_SB(0, 0), cB, voffB); PG8_STAGE(PG8_SA(0, 0), cA, voffA); PG8_STAGE(PG8_SB(0, 1), cB + hstep, voffB); PG8_STAGE(PG8_SA(0, 1), cA + hstep, voffA);
        if (wr == 1) PG8_BAR;
        PG8_WAIT_V(4); PG8_BAR;
        PG8_STAGE(PG8_SB(1, 0), cB + kstep, voffB); PG8_STAGE(PG8_SA(1, 0), cA + kstep, voffA); PG8_STAGE(PG8_SB(1, 1), cB + hstep + kstep, voffB);
        PG8_WAIT_V(6); PG8_BAR;
    }
    for (;;) {
        const bool has_next = S.next(ui + 1, nxt);
        const char* nA = has_next ? (const char*)g.A + (size_t)nxt.pm * tstep : cA; const char* nB = has_next ? (const char*)g.Bt + (size_t)nxt.pn * tstep : cB;
        for (int t = 0; t < nt; t += 2) {
            const bool last = (t == nt - 2);
            const char* a1 = cA + (size_t)(t + 1) * kstep;
            const char* a2 = last ? nA : cA + (size_t)(t + 2) * kstep; const char* b2 = last ? nB : cB + (size_t)(t + 2) * kstep;
            const char* a3 = a2 + kstep; const char* b3 = b2 + kstep;
            if (last && has_next) S.a_ready(nxt);
            if constexpr (SP2) {
            PG8_LDB(B0, 0, 0); PG8_LDB(B1, 0, 1); PG8_SCHED; PG8_LDA(At, 0, 0); PG8_STAGE(PG8_SA(1, 1), a1 + hstep, voffA);
            PG8_WAIT_V(8); PG8_WAIT_L(0); PG8_BAR; PG8_MMA(0, 0, At, B0); PG8_MMA(0, 1, At, B1); PG8_BAR; PG8_SCHED;
            PG8_LDA(At, 0, 1); PG8_STAGE(PG8_SB(0, 0), b2, voffB); PG8_STAGE(PG8_SB(0, 1), b2 + hstep, voffB); PG8_STAGE(PG8_SA(0, 0), a2, voffA);
            PG8_WAIT_V(8); PG8_WAIT_L(0); PG8_BAR; PG8_MMA(1, 0, At, B0); PG8_MMA(1, 1, At, B1); PG8_BAR; PG8_SCHED;
            PG8_LDB(B0, 1, 0); PG8_LDB(B1, 1, 1); PG8_SCHED; PG8_LDA(At, 1, 0); PG8_STAGE(PG8_SA(0, 1), a2 + hstep, voffA);
            PG8_WAIT_V(8); PG8_WAIT_L(0); PG8_BAR; PG8_MMA(0, 0, At, B0); PG8_MMA(0, 1, At, B1); PG8_BAR; PG8_SCHED;
            PG8_LDA(At, 1, 1); PG8_STAGE(PG8_SB(1, 0), b3, voffB); PG8_STAGE(PG8_SB(1, 1), b3 + hstep, voffB); PG8_STAGE(PG8_SA(1, 0), a3, voffA);
            PG8_WAIT_V(8); PG8_WAIT_L(0); PG8_BAR; PG8_MMA(1, 0, At, B0); PG8_MMA(1, 1, At, B1); PG8_BAR; PG8_SCHED;
            } else {
            PG8_LDB(B0, 0, 0); PG8_SCHED; PG8_LDA(At, 0, 0); PG8_STAGE(PG8_SA(1, 1), a1 + hstep, voffA);
            PG8_WAIT_L(8); PG8_BAR; PG8_WAIT_L(0); PG8_MMA(0, 0, At, B0); PG8_BAR; PG8_SCHED;
            PG8_LDB(B1, 0, 1); PG8_STAGE(PG8_SB(0, 0), b2, voffB);
            PG8_BAR; PG8_WAIT_L(0); PG8_MMA(0, 1, At, B1); PG8_BAR;
            PG8_LDA(At, 0, 1); PG8_STAGE(PG8_SA(0, 0), a2, voffA);
            PG8_BAR; PG8_WAIT_L(0); PG8_MMA(1, 0, At, B0); PG8_BAR; PG8_SCHED;
            PG8_STAGE(PG8_SB(0, 1), b2 + hstep, voffB);
            PG8_WAIT_V(6); PG8_BAR; PG8_MMA(1, 1, At, B1); PG8_BAR;
            PG8_LDB(B0, 1, 0); PG8_SCHED; PG8_LDA(At, 1, 0); PG8_STAGE(PG8_SA(0, 1), a2 + hstep, voffA);
            PG8_WAIT_L(8); PG8_BAR; PG8_WAIT_L(0); PG8_MMA(0, 0, At, B0); PG8_BAR; PG8_SCHED;
            PG8_LDB(B1, 1, 1); PG8_STAGE(PG8_SB(1, 0), b3, voffB);
            PG8_BAR; PG8_WAIT_L(0); PG8_MMA(0, 1, At, B1); PG8_BAR;
            PG8_LDA(At, 1, 1); PG8_STAGE(PG8_SA(1, 0), a3, voffA);
            PG8_BAR; PG8_WAIT_L(0); PG8_MMA(1, 0, At, B0); PG8_BAR; PG8_SCHED;
            PG8_STAGE(PG8_SB(1, 1), b3 + hstep, voffB);
            PG8_WAIT_V(6); PG8_BAR; PG8_MMA(1, 1, At, B1); PG8_BAR;
            }
        }
        if constexpr (ALIGN_EPI) { if (wr == 0) PG8_BAR; }
        if constexpr (!Epi::AFTER_DRAIN) { E(acc, cur, wr, wc, fr, fq); S.done(cur); }
        if (!has_next) break;
#pragma unroll
        for (int a = 0; a < 2; ++a)
#pragma unroll
            for (int b = 0; b < 2; ++b)
#pragma unroll
                for (int m = 0; m < 4; ++m)
#pragma unroll
                    for (int n = 0; n < 2; ++n) acc[a][b][m][n] = (f32x4){0.f, 0.f, 0.f, 0.f};
        cur = nxt; cA = nA; cB = nB; ++ui;
        if constexpr (ALIGN_EPI) { if (wr == 1) PG8_BAR; }
    }
    PG8_WAIT_V(0);
    if constexpr (!ALIGN_EPI) { if (wr == 0) PG8_BAR; }
    PG8_BAR;
    if constexpr (Epi::AFTER_DRAIN) { E.fused(acc, cur, wr, wc, fr, fq, lds, wid, lane); S.done(cur); }
#undef PG8_SA
#undef PG8_SB
#undef PG8_STAGE
#undef PG8_LDA
#undef PG8_LDB
#undef PG8_MMA
#undef PG8_WAIT_V
#undef PG8_WAIT_L
#undef PG8_BAR
#undef PG8_SCHED
}
}

#define LAS __attribute__((address_space(3)))
typedef unsigned short bf16_t;
typedef short bf16x8 __attribute__((ext_vector_type(8)));
typedef float f32x4 __attribute__((ext_vector_type(4)));
typedef float f32x16 __attribute__((ext_vector_type(16)));
typedef unsigned u32x4 __attribute__((ext_vector_type(4)));
typedef unsigned u32x2 __attribute__((ext_vector_type(2)));

constexpr int BATCH = 4, SEQ = 8192, DM = 1024, DFF = 2816, T = BATCH * SEQ;
constexpr float EPS = 1e-6f;
constexpr float LOG2E = 1.4426950408889634f;
constexpr size_t MiB = 1u << 20;
constexpr size_t WS_R1 = 0;
constexpr size_t WS_R2 = 192 * MiB;
constexpr size_t WS_R3 = 256 * MiB;
constexpr size_t WS_R5 = 320 * MiB;
constexpr size_t WS_W = 448 * MiB;
constexpr size_t WO_GU0 = 0, WO_D0 = 11 * MiB, WO_GU1 = 17 * MiB, WO_D1 = 28 * MiB, WO_IN = 34 * MiB, WO_OUT = 40 * MiB;
constexpr size_t WS_END = 492 * MiB;
constexpr int LDS_BYTES = 135168;

struct Params {
    const float* x; const float* norm_g;
    const float* ffn_wg[2]; const float* ffn_wu[2]; const float* ffn_wd[2];
    const float* diff_w_in; const float* diff_w_out; const float* diff_lambda; const float* diff_subln;
    const float* na_w_in; const float* na_w_out; const float* na_rpb;
    const float* gqa_w_in; const float* gqa_w_out; const float* gqa_qk_norm;
    float* out; unsigned char* ws;
    float inv_a[8]; float inv_c[16];
};

typedef const __attribute__((address_space(4))) Params* KP;
__device__ __forceinline__ KP kparams() { KP k = (KP)__builtin_amdgcn_kernarg_segment_ptr(); asm volatile("" : "+s"(k)); return k; }
struct Ids { int tid, lane, wave, vcu, G, bx, gw, NGW, gtid, NTH; };
__device__ __forceinline__ Ids ids() {
    Ids I; int t = threadIdx.x; asm volatile("" : "+v"(t)); int b = blockIdx.x; asm volatile("" : "+s"(b));
    I.tid = t; I.lane = t & 63; I.wave = __builtin_amdgcn_readfirstlane(t >> 6); I.G = gridDim.x; I.bx = b;
    I.vcu = (I.G % 8 == 0) ? (b % 8) * (I.G / 8) + b / 8 : b;
    I.gw = I.vcu * 8 + I.wave; I.NGW = I.G * 8; I.gtid = I.vcu * 512 + t; I.NTH = I.G * 512; return I;
}
__device__ __forceinline__ unsigned f2bf(float f) { unsigned u = __builtin_bit_cast(unsigned, f); return (u + 0x7fffu + ((u >> 16) & 1u)) >> 16; }
__device__ __forceinline__ unsigned pk2(float lo, float hi) { return f2bf(lo) | (f2bf(hi) << 16); }
__device__ __forceinline__ float bflo(unsigned w) { return __builtin_bit_cast(float, w << 16); }
__device__ __forceinline__ float bfhi(unsigned w) { return __builtin_bit_cast(float, w & 0xffff0000u); }
__device__ __forceinline__ float wave_sum(float v) {
#pragma unroll
    for (int o = 1; o < 64; o <<= 1) v += __shfl_xor(v, o);
    return v;
}
__device__ __forceinline__ void sincos_rr(float ang, float& s, float& c) {
    double rev = (double)ang * 0.15915494309189535; rev -= __builtin_floor(rev);
    const float fr = (float)rev;
    s = __builtin_amdgcn_sinf(fr); c = __builtin_amdgcn_cosf(fr);
}

__device__ __forceinline__ void transpose_item(const float* __restrict__ W, int K, int N, bf16_t* __restrict__ WT, int k0, int n0, int orow0, LAS float* scr, int lane) {
#pragma unroll 8
    for (int i = 0; i < 32; ++i) { const int kk = 2 * i + (lane >> 5); scr[kk * 33 + (lane & 31)] = W[(size_t)(k0 + kk) * N + n0 + (lane & 31)]; }
    asm volatile("s_waitcnt lgkmcnt(0)" ::: "memory");
    const int c = lane & 7;
#pragma unroll
    for (int j = 0; j < 4; ++j) { const int n = (lane >> 3) + 8 * j; const LAS float* s = scr + (8 * c) * 33 + n;
        u32x4 o; o.x = pk2(s[0 * 33], s[1 * 33]); o.y = pk2(s[2 * 33], s[3 * 33]); o.z = pk2(s[4 * 33], s[5 * 33]); o.w = pk2(s[6 * 33], s[7 * 33]);
        *(u32x4*)(WT + (size_t)(orow0 + n) * K + k0 + 8 * c) = o; }
    asm volatile("s_waitcnt lgkmcnt(0)" ::: "memory");
}
__device__ __forceinline__ void phase_convert(int layer, LAS unsigned char* lds) {
    const KP kp = kparams(); const Ids I = ids(); const int gw = I.gw, NGW = I.NGW, wave = I.wave, lane = I.lane;
    LAS float* scr = (LAS float*)(lds + wave * 16384);
    unsigned char* wsw = kp->ws + WS_W;
    const int kind = layer % 3, jj = layer / 3;
    const float* w_in; const float* w_out; int Nin;
    if (kind == 0) { w_in = kp->diff_w_in + (size_t)jj * DM * 3072; w_out = kp->diff_w_out + (size_t)jj * DM * DM; Nin = 3072; }
    else if (kind == 1) { w_in = kp->na_w_in + (size_t)jj * DM * 3072; w_out = kp->na_w_out + (size_t)jj * DM * DM; Nin = 3072; }
    else { w_in = kp->gqa_w_in + (size_t)jj * DM * 1536; w_out = kp->gqa_w_out + (size_t)jj * DM * DM; Nin = 1536; }
    constexpr int I_GU = (DM / 64) * (DFF / 32), I_D = (DFF / 64) * (DM / 32), I_OUT = (DM / 64) * (DM / 32);
    const int I_IN = (DM / 64) * (Nin / 32);
    const int total = 2 * (2 * I_GU + I_D) + I_IN + I_OUT;
    const size_t lofs = (size_t)layer * DM * DFF;
    for (int it = gw; it < total; it += NGW) {
        int r = it;
        if (r < 2 * (2 * I_GU + I_D)) {
            const int f = r / (2 * I_GU + I_D); r -= f * (2 * I_GU + I_D);
            bf16_t* gu = (bf16_t*)(wsw + (f ? WO_GU1 : WO_GU0)); bf16_t* wd = (bf16_t*)(wsw + (f ? WO_D1 : WO_D0));
            if (r < 2 * I_GU) {
                const int up = r / I_GU; r -= up * I_GU;
                const float* W = (up ? kp->ffn_wu[f] : kp->ffn_wg[f]) + lofs;
                const int nblk = DFF / 32, kb = r / nblk, nb = r % nblk, n0 = 32 * nb;
                transpose_item(W, DM, DFF, gu, 64 * kb, n0, 256 * (n0 / 128) + (n0 % 128) + 128 * up, scr, lane);
            } else {
                r -= 2 * I_GU;
                const int nblk = DM / 32, kb = r / nblk, nb = r % nblk, n0 = 32 * nb;
                transpose_item(kp->ffn_wd[f] + lofs, DFF, DM, wd, 64 * kb, n0, n0, scr, lane);
            }
        } else {
            r -= 2 * (2 * I_GU + I_D);
            if (r < I_IN) { const int nblk = Nin / 32, kb = r / nblk, nb = r % nblk, n0 = 32 * nb;
                transpose_item(w_in, DM, Nin, (bf16_t*)(wsw + WO_IN), 64 * kb, n0, n0, scr, lane); }
            else { r -= I_IN; const int nblk = DM / 32, kb = r / nblk, nb = r % nblk, n0 = 32 * nb;
                transpose_item(w_out, DM, DM, (bf16_t*)(wsw + WO_OUT), 64 * kb, n0, n0, scr, lane); }
        }
    }
}

__device__ __forceinline__ void phase_init_rows() {
    const KP kp = kparams(); const Ids I = ids(); const int gw = I.gw, NGW = I.NGW, lane = I.lane;
    const float* __restrict__ x = kp->x; float* __restrict__ h = kp->out; bf16_t* __restrict__ xn = (bf16_t*)(kp->ws + WS_R2); const float* __restrict__ g_pre = kp->norm_g;
    for (int row = gw; row < T; row += NGW) {
        const f32x4* xr = (const f32x4*)(x + (size_t)row * DM) + lane;
        f32x4 v[4]; float ss = 0.f;
#pragma unroll
        for (int j = 0; j < 4; ++j) { v[j] = xr[64 * j]; ss += (v[j].x * v[j].x + v[j].y * v[j].y) + (v[j].z * v[j].z + v[j].w * v[j].w); }
        const float rstd = 1.0f / sqrtf(wave_sum(ss) * (1.0f / DM) + EPS);
        f32x4* hr = (f32x4*)(h + (size_t)row * DM) + lane;
        u32x2* o8 = (u32x2*)(xn + (size_t)row * DM) + lane;
#pragma unroll
        for (int j = 0; j < 4; ++j) { hr[64 * j] = v[j]; const f32x4 g = ((const f32x4*)g_pre)[lane + 64 * j];
            u32x2 w; w.x = pk2(v[j].x * rstd * g.x, v[j].y * rstd * g.y); w.y = pk2(v[j].z * rstd * g.z, v[j].w * rstd * g.w); o8[64 * j] = w; }
    }
}
__device__ __forceinline__ void phase_rowwise(int layer, int sub) {
    const KP kp = kparams(); const Ids I = ids(); const int gw = I.gw, NGW = I.NGW, lane = I.lane;
    float* __restrict__ h = kp->out; const bf16_t* __restrict__ y = (const bf16_t*)(kp->ws + WS_R3); bf16_t* __restrict__ xn = (bf16_t*)(kp->ws + WS_R2);
    const float* gl = kp->norm_g + (size_t)layer * 6 * DM;
    const float coef = (sub == 1) ? 1.0f : 0.5f;
    const float* __restrict__ g_post = gl + (size_t)(2 * sub + 1) * DM;
    const float* __restrict__ g_pre = (sub < 2) ? gl + (size_t)(2 * sub + 2) * DM : (layer < 3 ? gl + (size_t)6 * DM : nullptr);
    for (int row = gw; row < T; row += NGW) {
        f32x4* hr = (f32x4*)(h + (size_t)row * DM) + lane;
        const u32x2* yr = (const u32x2*)(y + (size_t)row * DM) + lane;
        f32x4 hv[4], yv[4]; float ss = 0.f;
#pragma unroll
        for (int j = 0; j < 4; ++j) { hv[j] = hr[64 * j]; const u32x2 w = yr[64 * j]; yv[j] = (f32x4){bflo(w.x), bfhi(w.x), bflo(w.y), bfhi(w.y)};
            ss += (yv[j].x * yv[j].x + yv[j].y * yv[j].y) + (yv[j].z * yv[j].z + yv[j].w * yv[j].w); }
        const float rs = coef / sqrtf(wave_sum(ss) * (1.0f / DM) + EPS);
        float s2 = 0.f;
#pragma unroll
        for (int j = 0; j < 4; ++j) { const f32x4 g = ((const f32x4*)g_post)[lane + 64 * j];
            hv[j].x += yv[j].x * rs * g.x; hv[j].y += yv[j].y * rs * g.y; hv[j].z += yv[j].z * rs * g.z; hv[j].w += yv[j].w * rs * g.w;
            hr[64 * j] = hv[j];
            s2 += (hv[j].x * hv[j].x + hv[j].y * hv[j].y) + (hv[j].z * hv[j].z + hv[j].w * hv[j].w); }
        if (g_pre) {
            const float rstd = 1.0f / sqrtf(wave_sum(s2) * (1.0f / DM) + EPS);
            u32x2* o8 = (u32x2*)(xn + (size_t)row * DM) + lane;
#pragma unroll
            for (int j = 0; j < 4; ++j) { const f32x4 g = ((const f32x4*)g_pre)[lane + 64 * j];
                u32x2 w; w.x = pk2(hv[j].x * rstd * g.x, hv[j].y * rstd * g.y); w.y = pk2(hv[j].z * rstd * g.z, hv[j].w * rstd * g.w); o8[64 * j] = w; }
        }
    }
}

__device__ __forceinline__ void phase_post_a() {
    const KP kp = kparams(); const Ids I = ids(); const int gtid = I.gtid, NTH = I.NTH;
    bf16_t* raw = (bf16_t*)(kp->ws + WS_R1);
    float inv[8];
#pragma unroll
    for (int j = 0; j < 8; ++j) inv[j] = kp->inv_a[j];
    for (int item = gtid; item < T * 32; item += NTH) {
        const int t = item >> 5, w = item & 31;
        bf16_t* ptr = raw + (size_t)t * 3072 + (w >> 4) * 1024 + (w & 15) * 64;
        const u32x4 a = *(const u32x4*)ptr, b = *(const u32x4*)(ptr + 8);
        float x1[8] = {bflo(a.x), bfhi(a.x), bflo(a.y), bfhi(a.y), bflo(a.z), bfhi(a.z), bflo(a.w), bfhi(a.w)};
        float x2[8] = {bflo(b.x), bfhi(b.x), bflo(b.y), bfhi(b.y), bflo(b.z), bfhi(b.z), bflo(b.w), bfhi(b.w)};
        const float pos = (float)(t & (SEQ - 1));
        float y1[8], y2[8];
#pragma unroll
        for (int j = 0; j < 8; ++j) { float s, c; sincos_rr(pos * inv[j], s, c); y1[j] = x1[j] * c - x2[j] * s; y2[j] = x2[j] * c + x1[j] * s; }
        u32x4 oa, ob;
        oa.x = pk2(y1[0], y1[1]); oa.y = pk2(y1[2], y1[3]); oa.z = pk2(y1[4], y1[5]); oa.w = pk2(y1[6], y1[7]);
        ob.x = pk2(y2[0], y2[1]); ob.y = pk2(y2[2], y2[3]); ob.z = pk2(y2[4], y2[5]); ob.w = pk2(y2[6], y2[7]);
        *(u32x4*)ptr = oa; *(u32x4*)(ptr + 8) = ob;
    }
}
__device__ __forceinline__ void phase_post_c(int jj) {
    const KP kp = kparams(); const Ids I = ids(); const int gtid = I.gtid, NTH = I.NTH;
    bf16_t* raw = (bf16_t*)(kp->ws + WS_R1); const float* __restrict__ qk_g = kp->gqa_qk_norm + (size_t)jj * 128;
    float inv[16];
#pragma unroll
    for (int j = 0; j < 16; ++j) inv[j] = kp->inv_c[j];
    for (int item = gtid; item < T * 20; item += NTH) {
        const int t = item / 20, hd = item - t * 20;
        bf16_t* ptr = raw + (size_t)t * 1536 + hd * 64;
        const float* g = qk_g + (hd >= 16 ? 64 : 0);
        float x[64]; float ss = 0.f;
#pragma unroll
        for (int i = 0; i < 8; ++i) { const u32x4 a = *(const u32x4*)(ptr + 8 * i);
            x[8 * i + 0] = bflo(a.x); x[8 * i + 1] = bfhi(a.x); x[8 * i + 2] = bflo(a.y); x[8 * i + 3] = bfhi(a.y);
            x[8 * i + 4] = bflo(a.z); x[8 * i + 5] = bfhi(a.z); x[8 * i + 6] = bflo(a.w); x[8 * i + 7] = bfhi(a.w); }
#pragma unroll
        for (int i = 0; i < 64; ++i) ss += x[i] * x[i];
        const float rstd = 1.0f / sqrtf(ss * (1.0f / 64.0f) + EPS);
#pragma unroll
        for (int i = 0; i < 64; ++i) x[i] = x[i] * rstd * g[i];
        const int s_idx = t & (SEQ - 1);
        const float pr = (float)(s_idx >> 6), pc = (float)(s_idx & 63);
#pragma unroll
        for (int j = 0; j < 16; ++j) {
            float s, c; sincos_rr(pr * inv[j], s, c);
            const float a1 = x[j], a2 = x[j + 16]; x[j] = a1 * c - a2 * s; x[j + 16] = a2 * c + a1 * s;
            sincos_rr(pc * inv[j], s, c);
            const float b1 = x[32 + j], b2 = x[48 + j]; x[32 + j] = b1 * c - b2 * s; x[48 + j] = b2 * c + b1 * s;
        }
#pragma unroll
        for (int i = 0; i < 8; ++i) { u32x4 o; o.x = pk2(x[8 * i], x[8 * i + 1]); o.y = pk2(x[8 * i + 2], x[8 * i + 3]); o.z = pk2(x[8 * i + 4], x[8 * i + 5]); o.w = pk2(x[8 * i + 6], x[8 * i + 7]);
            *(u32x4*)(ptr + 8 * i) = o; }
    }
}
__device__ __forceinline__ void phase_vt(int ld, int voff, int VW, LAS unsigned char* lds) {
    const KP kp = kparams(); const Ids I = ids(); const int tid = I.tid, vcu = I.vcu, G = I.G;
    const bf16_t* __restrict__ raw = (const bf16_t*)(kp->ws + WS_R1); bf16_t* __restrict__ Vt = (bf16_t*)(kp->ws + WS_R3);
    const int ncb = VW / 256, ntiles = (T / 64) * ncb;
    for (int tile = vcu; tile < ntiles; tile += G) {
        const int tm = tile / ncb, cb = tile - tm * ncb;
        const int tok0 = tm * 64, b = tok0 / SEQ, s0 = tok0 - b * SEQ;
        { const int tok = tid >> 3, c8 = tid & 7;
          const bf16_t* src = raw + (size_t)(tok0 + tok) * ld + voff + cb * 256;
#pragma unroll
          for (int i = 0; i < 4; ++i) { const int ch = c8 + 8 * i; const u32x4 v = *(const u32x4*)(src + ch * 8); *(LAS u32x4*)(lds + tok * 528 + ch * 16) = v; } }
        __syncthreads();
        { const int col = tid >> 1, half = tid & 1;
          unsigned w[16];
#pragma unroll
          for (int i = 0; i < 16; ++i) { const unsigned lo = *(const LAS unsigned short*)(lds + (32 * half + 2 * i) * 528 + col * 2);
              const unsigned hi = *(const LAS unsigned short*)(lds + (32 * half + 2 * i + 1) * 528 + col * 2); w[i] = lo | (hi << 16); }
          bf16_t* dst = Vt + ((size_t)b * VW + cb * 256 + col) * SEQ + s0 + 32 * half;
#pragma unroll
          for (int i = 0; i < 4; ++i) { u32x4 o; o.x = w[4 * i]; o.y = w[4 * i + 1]; o.z = w[4 * i + 2]; o.w = w[4 * i + 3]; *(u32x4*)(dst + 8 * i) = o; } }
        __syncthreads();
    }
}
__device__ __forceinline__ void phase_subln(int layer, int jj) {
    const KP kp = kparams(); const Ids I = ids(); const int gw = I.gw, NGW = I.NGW, lane = I.lane;
    const bf16_t* __restrict__ Opart = (const bf16_t*)(kp->ws + WS_R5); bf16_t* __restrict__ xo = (bf16_t*)(kp->ws + WS_R2);
    const float* __restrict__ lamv = kp->diff_lambda + (size_t)jj * 256; const float* __restrict__ subg = kp->diff_subln + (size_t)jj * 128;
    const float lam_init = 0.8f - 0.6f * expf(-0.3f * (float)layer);
    const float d1 = wave_sum(lamv[lane] * lamv[64 + lane]), d2 = wave_sum(lamv[128 + lane] * lamv[192 + lane]);
    const float lam = expf(d1) - expf(d2) + lam_init;
    const float osc = 1.0f - lam_init;
    const int sub = lane & 15;
    float g[8];
#pragma unroll
    for (int i = 0; i < 8; ++i) g[i] = subg[8 * sub + i] * osc;
    for (int it = gw; it < T * 2; it += NGW) {
        const int item = it * 4 + (lane >> 4); const int t = item >> 3, hd = item & 7;
        const bf16_t* src = Opart + (size_t)t * 2048 + hd * 256 + 8 * sub;
        const u32x4 a = *(const u32x4*)src, b = *(const u32x4*)(src + 128);
        float o[8];
        o[0] = bflo(a.x) - lam * bflo(b.x); o[1] = bfhi(a.x) - lam * bfhi(b.x); o[2] = bflo(a.y) - lam * bflo(b.y); o[3] = bfhi(a.y) - lam * bfhi(b.y);
        o[4] = bflo(a.z) - lam * bflo(b.z); o[5] = bfhi(a.z) - lam * bfhi(b.z); o[6] = bflo(a.w) - lam * bflo(b.w); o[7] = bfhi(a.w) - lam * bfhi(b.w);
        float ss = 0.f;
#pragma unroll
        for (int i = 0; i < 8; ++i) ss += o[i] * o[i];
        ss += __shfl_xor(ss, 1); ss += __shfl_xor(ss, 2); ss += __shfl_xor(ss, 4); ss += __shfl_xor(ss, 8);
        const float rstd = 1.0f / sqrtf(ss * (1.0f / 128.0f) + EPS);
        u32x4 w; w.x = pk2(o[0] * rstd * g[0], o[1] * rstd * g[1]); w.y = pk2(o[2] * rstd * g[2], o[3] * rstd * g[3]);
        w.z = pk2(o[4] * rstd * g[4], o[5] * rstd * g[5]); w.w = pk2(o[6] * rstd * g[6], o[7] * rstd * g[7]);
        *(u32x4*)(xo + (size_t)t * DM + hd * 128 + 8 * sub) = w;
    }
}

__device__ __forceinline__ unsigned cvtpk(float lo, float hi) { unsigned r; asm volatile("v_cvt_pk_bf16_f32 %0, %1, %2" : "=v"(r) : "v"(lo), "v"(hi)); return r; }
template <int DV, int MODE>
__device__ __forceinline__ void attn_unit(LAS unsigned char* lds, const bf16_t* __restrict__ Qp, int ldq, const bf16_t* __restrict__ Kp, int ldk,
                                          const bf16_t* __restrict__ Vp, bf16_t* __restrict__ Op, int ldo, int t_lo, int t_hi, const float* __restrict__ rpb_h, int r4, int tid) {
    constexpr int KROW = 144, KB_BYTES = 64 * KROW, VB_BYTES = DV * KROW, BUF = KB_BYTES + VB_BYTES, NDB = DV / 32, NVP = DV / 64;
    constexpr float cscale = 0.125f * LOG2E;
    const int lane = tid & 63, wid = __builtin_amdgcn_readfirstlane(tid >> 6), j = lane & 31, hi = lane >> 5;
    bf16x8 qf[4];
    { const bf16_t* qrow = Qp + (size_t)(wid * 32 + j) * ldq + hi * 8;
#pragma unroll
      for (int d0 = 0; d0 < 4; ++d0) qf[d0] = *(const bf16x8*)(qrow + d0 * 16); }
    const int srow = tid >> 3, sch = tid & 7;
    const bf16_t* kg = Kp + (size_t)srow * ldk + sch * 8;
    const bf16_t* vg = Vp + (size_t)srow * SEQ + sch * 8;
    const int ks_off = srow * KROW + sch * 16;
    const int kap = (j & 0x13) | ((j & 4) << 1) | ((j & 8) >> 1);
    const int kr_off = kap * KROW + hi * 16;
    const int vr_off = KB_BYTES + j * KROW + hi * 16;
    LAS float* rp = (LAS float*)(lds + 2 * BUF);
    int qr = 0, qc = 0, r0 = 0, cs = 0;
    if (MODE == 1) {
        qr = r4 + (wid >> 1); qc = (wid & 1) * 32 + j;
        r0 = qr - 4; r0 = r0 < 0 ? 0 : (r0 > 120 ? 120 : r0);
        cs = qc - 8; cs = cs < 0 ? 0 : (cs > 48 ? 48 : cs);
        for (int i = tid; i < 15 * 31; i += 512) rp[i] = rpb_h[i] * LOG2E;
    }
    u32x4 kreg, vreg[NVP];
    kreg = *(const u32x4*)(kg + (size_t)t_lo * 64 * ldk);
#pragma unroll
    for (int pt = 0; pt < NVP; ++pt) vreg[pt] = *(const u32x4*)(vg + (size_t)pt * 64 * SEQ + t_lo * 64);
    *(LAS u32x4*)(lds + ks_off) = kreg;
#pragma unroll
    for (int pt = 0; pt < NVP; ++pt) *(LAS u32x4*)(lds + KB_BYTES + pt * 64 * KROW + ks_off) = vreg[pt];
    __syncthreads();
    float m_run = -INFINITY, l_run = 0.f;
    f32x16 o[NDB];
#pragma unroll
    for (int db = 0; db < NDB; ++db)
#pragma unroll
        for (int r = 0; r < 16; ++r) o[db][r] = 0.f;
    for (int t = t_lo; t < t_hi; ++t) {
        const int bufoff = ((t - t_lo) & 1) * BUF;
        const bool more = (t + 1 < t_hi);
        if (more) {
            kreg = *(const u32x4*)(kg + (size_t)(t + 1) * 64 * ldk);
#pragma unroll
            for (int pt = 0; pt < NVP; ++pt) vreg[pt] = *(const u32x4*)(vg + (size_t)pt * 64 * SEQ + (t + 1) * 64);
        }
        bool active = true;
        if (MODE == 1) active = (t >= r0) && (t < r0 + 8);
        if (active) {
            f32x16 s0, s1;
#pragma unroll
            for (int r = 0; r < 16; ++r) { s0[r] = 0.f; s1[r] = 0.f; }
#pragma unroll
            for (int d0 = 0; d0 < 4; ++d0) {
                const bf16x8 k0 = *(const LAS bf16x8*)(lds + bufoff + kr_off + d0 * 32);
                const bf16x8 k1 = *(const LAS bf16x8*)(lds + bufoff + kr_off + 32 * KROW + d0 * 32);
                s0 = __builtin_amdgcn_mfma_f32_32x32x16_bf16(k0, qf[d0], s0, 0, 0, 0);
                s1 = __builtin_amdgcn_mfma_f32_32x32x16_bf16(k1, qf[d0], s1, 0, 0, 0);
            }
            if (MODE == 1) {
                const int dr = t - qr + 7;
#pragma unroll
                for (int r = 0; r < 16; ++r) {
                    { const int kc = 16 * (r >> 3) + 8 * hi + (r & 7); const bool ok = (kc >= cs) && (kc < cs + 16);
                      const float bias = rp[ok ? dr * 31 + (kc - qc + 15) : 0]; s0[r] = ok ? __builtin_fmaf(s0[r], cscale, bias) : -INFINITY; }
                    { const int kc = 32 + 16 * (r >> 3) + 8 * hi + (r & 7); const bool ok = (kc >= cs) && (kc < cs + 16);
                      const float bias = rp[ok ? dr * 31 + (kc - qc + 15) : 0]; s1[r] = ok ? __builtin_fmaf(s1[r], cscale, bias) : -INFINITY; }
                }
            }
            constexpr float sc = (MODE == 1) ? 1.0f : cscale;
            float mx = fmaxf(s0[0], s1[0]);
#pragma unroll
            for (int r = 1; r < 16; ++r) mx = fmaxf(mx, fmaxf(s0[r], s1[r]));
            mx = fmaxf(mx, __shfl_xor(mx, 32));
            const float m_new = fmaxf(m_run, mx * sc);
            const float alpha = __builtin_amdgcn_exp2f(m_run - m_new);
            m_run = m_new;
            float ls = 0.f;
#pragma unroll
            for (int r = 0; r < 16; ++r) { s0[r] = __builtin_amdgcn_exp2f(__builtin_fmaf(s0[r], sc, -m_new)); s1[r] = __builtin_amdgcn_exp2f(__builtin_fmaf(s1[r], sc, -m_new)); ls += s0[r] + s1[r]; }
            l_run = l_run * alpha + ls;
#pragma unroll
            for (int db = 0; db < NDB; ++db)
#pragma unroll
                for (int r = 0; r < 16; ++r) o[db][r] *= alpha;
            bf16x8 pf[2][2];
#pragma unroll
            for (int c = 0; c < 2; ++c) {
                u32x4 w0, w1;
                w0.x = cvtpk(s0[8 * c + 0], s0[8 * c + 1]); w0.y = cvtpk(s0[8 * c + 2], s0[8 * c + 3]); w0.z = cvtpk(s0[8 * c + 4], s0[8 * c + 5]); w0.w = cvtpk(s0[8 * c + 6], s0[8 * c + 7]);
                w1.x = cvtpk(s1[8 * c + 0], s1[8 * c + 1]); w1.y = cvtpk(s1[8 * c + 2], s1[8 * c + 3]); w1.z = cvtpk(s1[8 * c + 4], s1[8 * c + 5]); w1.w = cvtpk(s1[8 * c + 6], s1[8 * c + 7]);
                pf[0][c] = __builtin_bit_cast(bf16x8, w0); pf[1][c] = __builtin_bit_cast(bf16x8, w1);
            }
#pragma unroll
            for (int db = 0; db < NDB; ++db)
#pragma unroll
                for (int kb = 0; kb < 2; ++kb)
#pragma unroll
                    for (int c = 0; c < 2; ++c) {
                        const bf16x8 vf = *(const LAS bf16x8*)(lds + bufoff + vr_off + db * 32 * KROW + kb * 64 + c * 32);
                        o[db] = __builtin_amdgcn_mfma_f32_32x32x16_bf16(vf, pf[kb][c], o[db], 0, 0, 0);
                    }
        }
        if (more) {
            const int nb = BUF - bufoff;
            *(LAS u32x4*)(lds + nb + ks_off) = kreg;
#pragma unroll
            for (int pt = 0; pt < NVP; ++pt) *(LAS u32x4*)(lds + nb + KB_BYTES + pt * 64 * KROW + ks_off) = vreg[pt];
        }
        __syncthreads();
    }
    const float l_tot = l_run + __shfl_xor(l_run, 32);
    const float inv = 1.0f / l_tot;
    bf16_t* orow = Op + (size_t)(wid * 32 + j) * ldo + 4 * hi;
#pragma unroll
    for (int db = 0; db < NDB; ++db)
#pragma unroll
        for (int g = 0; g < 4; ++g) {
            u32x2 w; w.x = cvtpk(o[db][4 * g] * inv, o[db][4 * g + 1] * inv); w.y = cvtpk(o[db][4 * g + 2] * inv, o[db][4 * g + 3] * inv);
            *(u32x2*)(orow + 32 * db + 8 * g) = w;
        }
}
template <int KIND>
__device__ __forceinline__ void phase_attn(LAS unsigned char* lds, int jj) {
    constexpr int DV = (KIND == 0) ? 128 : 64, MODE = (KIND == 1) ? 1 : 0;
    constexpr int ldq = (KIND == 2) ? 1536 : 3072, kv_shift = (KIND == 2) ? 2 : 0, vh_shift = (KIND == 0) ? 1 : (KIND == 2 ? 2 : 0), VW = (KIND == 2) ? 256 : 1024, ldo = (KIND == 0) ? 2048 : 1024;
    const KP kp = kparams(); const Ids I = ids();
    const bf16_t* Q = (const bf16_t*)(kp->ws + WS_R1); const bf16_t* K = Q + 1024; const bf16_t* Vt = (const bf16_t*)(kp->ws + WS_R3);
    bf16_t* O = (bf16_t*)(kp->ws + (KIND == 0 ? WS_R5 : WS_R2));
    const float* rpb = (KIND == 1) ? kp->na_rpb + (size_t)jj * 16 * 465 : nullptr;
    constexpr int NU = BATCH * 16 * 32;
    for (int u = I.vcu; u < NU; u += I.G) {
        const int bh = u >> 5, qb = u & 31, b = bh >> 4, hd = bh & 15;
        const bf16_t* Qp = Q + (size_t)(b * SEQ + qb * 256) * ldq + hd * 64;
        const bf16_t* Kp = K + (size_t)(b * SEQ) * ldq + (hd >> kv_shift) * 64;
        const bf16_t* Vp = Vt + ((size_t)b * VW + (size_t)(hd >> vh_shift) * DV) * SEQ;
        bf16_t* Op = O + (size_t)(b * SEQ + qb * 256) * ldo + hd * DV;
        int t_lo = 0, t_hi = SEQ / 64;
        if (MODE == 1) { const int r4 = 4 * qb; t_lo = r4 - 4; t_lo = t_lo < 0 ? 0 : (t_lo > 120 ? 120 : t_lo); int rl = r4 + 3 - 4; rl = rl < 0 ? 0 : (rl > 120 ? 120 : rl); t_hi = rl + 8; }
        attn_unit<DV, MODE>(lds, Qp, ldq, Kp, ldq, Vp, Op, ldo, t_lo, t_hi, MODE == 1 ? rpb + hd * 465 : nullptr, 4 * qb, I.tid);
    }
}
template <bool SWIGLU>
__device__ __forceinline__ void phase_gemm(LAS unsigned char* lds, int which, int f, int Nin) {
    const KP kp = kparams(); int b = blockIdx.x; asm volatile("" : "+s"(b)); const int G = gridDim.x;
    unsigned char* ws = kp->ws;
    if (SWIGLU) {
        pg8::Gemm g{(const bf16_t*)(ws + WS_R2), (const bf16_t*)(ws + WS_W + (f ? WO_GU1 : WO_GU0)), T, 2 * DFF, DM}; pg8::StaticOrder S; S.init(T, 2 * DFF, G, b);
        pg8::EpiSwiglu E{(bf16_t*)(ws + WS_R1), DFF};
        pg8::gemm_phase<pg8::EpiSwiglu, pg8::StaticOrder, true, true>(lds, g, S, E);
    } else {
        const bf16_t* A; const bf16_t* Bt; bf16_t* O; int N, K;
        if (which == 1) { A = (const bf16_t*)(ws + WS_R1); Bt = (const bf16_t*)(ws + WS_W + (f ? WO_D1 : WO_D0)); O = (bf16_t*)(ws + WS_R3); N = DM; K = DFF; }
        else if (which == 2) { A = (const bf16_t*)(ws + WS_R2); Bt = (const bf16_t*)(ws + WS_W + WO_IN); O = (bf16_t*)(ws + WS_R1); N = Nin; K = DM; }
        else { A = (const bf16_t*)(ws + WS_R2); Bt = (const bf16_t*)(ws + WS_W + WO_OUT); O = (bf16_t*)(ws + WS_R3); N = DM; K = DM; }
        pg8::Gemm g{A, Bt, T, N, K}; pg8::StaticOrder S; S.init(T, N, G, b);
        pg8::EpiStore E{O, N};
        pg8::gemm_phase<pg8::EpiStore, pg8::StaticOrder, true, true>(lds, g, S, E);
    }
}

__global__ void __launch_bounds__(512, 2) fwd_kernel(Params p_unused) {
    extern __shared__ __attribute__((aligned(16))) unsigned char lds_raw[];
    LAS unsigned char* lds = (LAS unsigned char*)lds_raw;
    cg::grid_group grid = cg::this_grid();

    phase_convert(0, lds);
    phase_init_rows();
    grid.sync();

    for (int layer = 0; layer < 4; ++layer) {
        const int kind = layer % 3, jj = layer / 3;
        const int Nin = (kind == 2) ? 1536 : 3072;
        for (int sub = 0; sub < 3; ++sub) {
            if (sub != 1) {
                phase_gemm<true>(lds, 0, sub >> 1, 0);
                grid.sync();
            }
            for (int rep = 0; rep < 2; ++rep) {
                if (rep == 1) {
                    if (sub != 1) break;
                    if (kind == 0) {
                        phase_post_a();
                        phase_vt(3072, 2048, 1024, lds);
                        grid.sync();
                        phase_attn<0>(lds, jj);
                        grid.sync();
                        phase_subln(layer, jj);
                    } else if (kind == 1) {
                        phase_vt(3072, 2048, 1024, lds);
                        grid.sync();
                        phase_attn<1>(lds, jj);
                    } else {
                        phase_post_c(jj);
                        phase_vt(1536, 1280, 256, lds);
                        grid.sync();
                        phase_attn<2>(lds, jj);
                    }
                    grid.sync();
                }
                phase_gemm<false>(lds, rep == 1 ? 3 : (sub == 1 ? 2 : 1), sub >> 1, Nin);
                grid.sync();
            }
            phase_rowwise(layer, sub);
            if (sub == 2 && layer < 3) phase_convert(layer + 1, lds);
            grid.sync();
        }
    }
}

extern "C" void kernel_launch(void* const* d_in, const int* in_sizes, int n_in, void* d_out, int out_size, void* d_ws, size_t ws_size, hipStream_t stream) {
    static int grid_blocks = 0;
    if (grid_blocks == 0) {
        if (n_in != 18 || in_sizes[0] != T * DM || out_size != T * DM || ws_size < WS_END) {
            fprintf(stderr, "kernel_launch: unexpected shapes: n_in %d in0 %d out %d ws %zu (need %zu)\n", n_in, n_in > 0 ? in_sizes[0] : -1, out_size, ws_size, (size_t)WS_END);
            grid_blocks = -1; return; }
        int dev = 0, cus = 0, per_cu = 0;
        hipGetDevice(&dev);
        hipDeviceGetAttribute(&cus, hipDeviceAttributeMultiprocessorCount, dev);
        if (hipFuncSetAttribute((const void*)fwd_kernel, hipFuncAttributeMaxDynamicSharedMemorySize, LDS_BYTES) != hipSuccess) { fprintf(stderr, "kernel_launch: hipFuncSetAttribute failed\n"); grid_blocks = -1; return; }
        if (hipOccupancyMaxActiveBlocksPerMultiprocessor(&per_cu, (const void*)fwd_kernel, 512, LDS_BYTES) != hipSuccess || per_cu < 1) { fprintf(stderr, "kernel_launch: occupancy query failed (%d)\n", per_cu); per_cu = 1; }
        (void)hipGetLastError();
        grid_blocks = cus * per_cu;
    }
    if (grid_blocks < 0) return;
    Params p{};
    p.x = (const float*)d_in[0]; p.norm_g = (const float*)d_in[1];
    p.ffn_wg[0] = (const float*)d_in[2]; p.ffn_wu[0] = (const float*)d_in[3]; p.ffn_wd[0] = (const float*)d_in[4];
    p.ffn_wg[1] = (const float*)d_in[5]; p.ffn_wu[1] = (const float*)d_in[6]; p.ffn_wd[1] = (const float*)d_in[7];
    p.diff_w_in = (const float*)d_in[8]; p.diff_w_out = (const float*)d_in[9]; p.diff_lambda = (const float*)d_in[10]; p.diff_subln = (const float*)d_in[11];
    p.na_w_in = (const float*)d_in[12]; p.na_w_out = (const float*)d_in[13]; p.na_rpb = (const float*)d_in[14];
    p.gqa_w_in = (const float*)d_in[15]; p.gqa_w_out = (const float*)d_in[16]; p.gqa_qk_norm = (const float*)d_in[17];
    p.out = (float*)d_out; p.ws = (unsigned char*)d_ws;
    for (int j = 0; j < 8; ++j) p.inv_a[j] = (float)pow(500000.0, -(double)(2 * j) / 16.0);
    for (int j = 0; j < 16; ++j) p.inv_c[j] = (float)pow(10000.0, -(double)(2 * j) / 32.0);
    void* args[] = {&p};
    hipError_t e = hipLaunchCooperativeKernel((const void*)fwd_kernel, dim3(grid_blocks), dim3(512), args, LDS_BYTES, stream);
    if (e != hipSuccess) fprintf(stderr, "kernel_launch: cooperative launch failed: %s (grid %d)\n", hipGetErrorString(e), grid_blocks);
}
```

```cpp
#include <hip/hip_runtime.h>
#include <hip/hip_cooperative_groups.h>
#include <cstdio>
#include <cstdint>
#include <cmath>
namespace cg = cooperative_groups;
namespace pg8 {
#define PG8_LAS __attribute__((address_space(3)))
typedef unsigned short bf16_t;
typedef short bf16x8 __attribute__((ext_vector_type(8)));
typedef float f32x4 __attribute__((ext_vector_type(4)));
typedef unsigned u32x4 __attribute__((ext_vector_type(4)));
constexpr int BM = 256, BK = 64, HALF = 128, HTB = HALF * BK * 2  , STAGE_BYTES = 8 * HTB, NXCD = 8, WGM = 8;

__host__ __device__ __forceinline__ int lds_byte(int r, int c) { const int st = (r >> 4) * 2 + (c >> 5), rr = r & 15, cc = c & 31, ob = rr * 64 + cc * 2; return st * 1024 + (ob ^ (((ob >> 9) & 1) << 5)); }
__host__ __device__ __forceinline__ void stage_rc(int b, int& R, int& C) { const int st = b / 1024, sb = b % 1024, swz = sb ^ (((sb >> 9) & 1) << 5); R = (st >> 1) * 16 + swz / 64; C = (st & 1) * 32 + (swz % 64) / 2; }
__host__ __device__ __forceinline__ int perm32(int rho) { const int n = rho >> 4, i = rho & 15; return 8 * (i >> 2) + 4 * n + (i & 3); }

struct Unit { int pm, pn; };
struct Gemm { const bf16_t* A; const bf16_t* Bt; int M, N, K; };

struct StaticOrder {
    int nM, nN, nwg, G, c;
    __host__ __device__ void init(int M, int N, int G_, int c_) { nM = M / BM; nN = N / BM; nwg = nM * nN; G = G_; c = c_; }
    __host__ __device__ bool next(int i, Unit& u) const {
        const long L = (long)i * G + c; if (L >= nwg) return false;
        int wgid = (int)L; { const int q = nwg / NXCD, r = nwg % NXCD, xcd = wgid % NXCD, off = wgid / NXCD; wgid = (xcd < r ? xcd * (q + 1) : r * (q + 1) + (xcd - r) * q) + off; }
        const int nig = WGM * nN, gid = wgid / nig, fm = gid * WGM, gsz = (nM - fm) < WGM ? (nM - fm) : WGM;
        u.pm = fm + ((wgid % nig) % gsz); u.pn = (wgid % nig) / gsz; return true;
    }
    __device__ __forceinline__ void a_ready(const Unit&) const {}
    __device__ __forceinline__ void done(const Unit&) const {}
};

__device__ __forceinline__ unsigned cvt_pk_bf16(float lo, float hi) { unsigned r; asm volatile("v_cvt_pk_bf16_f32 %0, %1, %2" : "=v"(r) : "v"(lo), "v"(hi)); return r; }
typedef float f32x2 __attribute__((ext_vector_type(2)));
struct EpiStore {
    static constexpr bool PERM = true, AFTER_DRAIN = false;
    bf16_t* O; int ldc; int scale_cols; float scale0;
    __device__ __forceinline__ void operator()(const f32x4 (&acc)[2][2][4][2], const Unit& u, int wr, int wc, int fr, int fq) const {
        const int row0 = u.pm * BM + wr * 64 + fr; const int col0 = u.pn * BM + wc * 32 + 8 * fq;
        const float sc = (u.pn * BM < scale_cols) ? scale0 : 1.0f;
#pragma unroll
        for (int ai = 0; ai < 2; ++ai)
#pragma unroll
            for (int m = 0; m < 4; ++m) { bf16_t* rowp = O + (size_t)(row0 + ai * HALF + m * 16) * ldc + col0;
#pragma unroll
                for (int bj = 0; bj < 2; ++bj) { const f32x4 v0 = acc[ai][bj][m][0] * sc, v1 = acc[ai][bj][m][1] * sc;
                    u32x4 w; w.x = cvt_pk_bf16(v0[0], v0[1]); w.y = cvt_pk_bf16(v0[2], v0[3]); w.z = cvt_pk_bf16(v1[0], v1[1]); w.w = cvt_pk_bf16(v1[2], v1[3]);
                    *(u32x4*)(rowp + bj * HALF) = w; } }
    }
};
__device__ __forceinline__ float silu_mul(float g, float u) { const float e = __builtin_amdgcn_exp2f(g * -1.4426950408889634f); return g * __builtin_amdgcn_rcpf(1.0f + e) * u; }
struct EpiSwiglu {
    static constexpr bool PERM = true, AFTER_DRAIN = false;
    bf16_t* O; int ldc;
    __device__ __forceinline__ void operator()(const f32x4 (&acc)[2][2][4][2], const Unit& u, int wr, int wc, int fr, int fq) const {
        const int row0 = u.pm * BM + wr * 64 + fr; const int col0 = u.pn * HALF + wc * 32 + 8 * fq;
#pragma unroll
        for (int ai = 0; ai < 2; ++ai)
#pragma unroll
            for (int m = 0; m < 4; ++m) { bf16_t* rowp = O + (size_t)(row0 + ai * HALF + m * 16) * ldc + col0;
                const f32x4 g0 = acc[ai][0][m][0], g1 = acc[ai][0][m][1], u0 = acc[ai][1][m][0], u1 = acc[ai][1][m][1];
                u32x4 w; w.x = cvt_pk_bf16(silu_mul(g0[0], u0[0]), silu_mul(g0[1], u0[1])); w.y = cvt_pk_bf16(silu_mul(g0[2], u0[2]), silu_mul(g0[3], u0[3]));
                w.z = cvt_pk_bf16(silu_mul(g1[0], u1[0]), silu_mul(g1[1], u1[1])); w.w = cvt_pk_bf16(silu_mul(g1[2], u1[2]), silu_mul(g1[3], u1[3]));
                *(u32x4*)rowp = w; }
    }
};
template <class Epi, class Sched, bool ALIGN_EPI = false, bool SP2 = false>
__device__ __forceinline__ void gemm_phase(PG8_LAS unsigned char* lds, const Gemm g, const Sched& S, const Epi& E) {
    int tid_l = threadIdx.x; asm volatile("" : "+v"(tid_l));
    const int tid = tid_l, wid = __builtin_amdgcn_readfirstlane(tid >> 6), lane = tid & 63, wr = wid >> 2, wc = wid & 3, fr = lane & 15, fq = lane >> 4;
    const int K = g.K, nt = K / BK;
    unsigned voffA[2], voffB[2];
#pragma unroll
    for (int i = 0; i < 2; ++i) { int R, C; stage_rc(tid * 16 + i * 8192, R, C); const int Rb = Epi::PERM ? ((R & ~31) + perm32(R & 31)) : R;
        voffA[i] = (unsigned)(R * K + C) * 2u; voffB[i] = (unsigned)(Rb * K + C) * 2u; }
    const size_t kstep = (size_t)(BK * 2);
    const size_t hstep = (size_t)HALF * K * 2;
    const size_t tstep = 2 * hstep;
    const unsigned ldsw = (unsigned)wid * 1024u;
    const int aoff = lds_byte(wr * 64 + fr, fq * 8), boff = lds_byte(wc * 32 + fr, fq * 8);
#define PG8_SA(b, h) (((b) * 2 + (h)) * HTB)
#define PG8_SB(b, h) ((4 + (b) * 2 + (h)) * HTB)
#define PG8_STAGE(bufoff, gbase, voff) do { _Pragma("unroll") for (int _i = 0; _i < 2; ++_i) \
        __builtin_amdgcn_global_load_lds((const unsigned*)((const char*)(gbase) + (voff)[_i]), (PG8_LAS unsigned*)(lds + (bufoff) + ldsw + _i * 8192), 16, 0, 0); } while (0)
#define PG8_LDA(dst, b, h) do { _Pragma("unroll") for (int m = 0; m < 4; ++m) _Pragma("unroll") for (int k = 0; k < 2; ++k) dst[m][k] = *(const PG8_LAS bf16x8*)(lds + PG8_SA(b, h) + aoff + m * 2048 + k * 1024); } while (0)
#define PG8_LDB(dst, b, h) do { _Pragma("unroll") for (int n = 0; n < 2; ++n) _Pragma("unroll") for (int k = 0; k < 2; ++k) dst[n][k] = *(const PG8_LAS bf16x8*)(lds + PG8_SB(b, h) + boff + n * 2048 + k * 1024); } while (0)
#define PG8_MMA(ai, bj, At, Bt) do { __builtin_amdgcn_s_setprio(1); _Pragma("unroll") for (int m = 0; m < 4; ++m) _Pragma("unroll") for (int n = 0; n < 2; ++n) _Pragma("unroll") for (int k = 0; k < 2; ++k) \
        acc[ai][bj][m][n] = __builtin_amdgcn_mfma_f32_16x16x32_bf16(Bt[n][k], At[m][k], acc[ai][bj][m][n], 0, 0, 0); __builtin_amdgcn_s_setprio(0); } while (0)
#define PG8_WAIT_V(n) asm volatile("s_waitcnt vmcnt(" #n ")" ::: "memory")
#define PG8_WAIT_L(n) asm volatile("s_waitcnt lgkmcnt(" #n ")" ::: "memory")
#define PG8_BAR __builtin_amdgcn_s_barrier()
#define PG8_SCHED __builtin_amdgcn_sched_barrier(0)
    Unit cur, nxt; int ui = 0;
    if (!S.next(0, cur)) return;
    f32x4 acc[2][2][4][2];
#pragma unroll
    for (int a = 0; a < 2; ++a)
#pragma unroll
        for (int b = 0; b < 2; ++b)
#pragma unroll
            for (int m = 0; m < 4; ++m)
#pragma unroll
                for (int n = 0; n < 2; ++n) acc[a][b][m][n] = (f32x4){0.f, 0.f, 0.f, 0.f};
    bf16x8 At[4][2], B0[2][2], B1[2][2];
    const char* cA = (const char*)g.A + (size_t)cur.pm * tstep; const char* cB = (const char*)g.Bt + (size_t)cur.pn * tstep;
    S.a_ready(cur);
    if constexpr (SP2) {
        PG8_STAGE(PG8_SB(0, 0), cB, voffB); PG8_STAGE(PG8_SB(0, 1), cB + hstep, voffB); PG8_STAGE(PG8_SA(0, 0), cA, voffA); PG8_STAGE(PG8_SA(0, 1), cA + hstep, voffA);
        if (wr == 1) PG8_BAR;
        PG8_WAIT_V(2); PG8_BAR;
        PG8_STAGE(PG8_SB(1, 0), cB + kstep, voffB); PG8_STAGE(PG8_SA(1, 0), cA + kstep, voffA); PG8_STAGE(PG8_SB(1, 1), cB + hstep + kstep, voffB);
        PG8_WAIT_V(6); PG8_BAR;
    } else {
        PG8_STAGE(PG8_SB(0, 0), cB, voffB); PG8_STAGE(PG8_SA(0, 0), cA, voffA); PG8_STAGE(PG8_SB(0, 1), cB + hstep, voffB); PG8_STAGE(PG8_SA(0, 1), cA + hstep, voffA);
        if (wr == 1) PG8_BAR;
        PG8_WAIT_V(4); PG8_BAR;
        PG8_STAGE(PG8_SB(1, 0), cB + kstep, voffB); PG8_STAGE(PG8_SA(1, 0), cA + kstep, voffA); PG8_STAGE(PG8_SB(1, 1), cB + hstep + kstep, voffB);
        PG8_WAIT_V(6); PG8_BAR;
    }
    for (;;) {
        const bool has_next = S.next(ui + 1, nxt);
        const char* nA = has_next ? (const char*)g.A + (size_t)nxt.pm * tstep : cA; const char* nB = has_next ? (const char*)g.Bt + (size_t)nxt.pn * tstep : cB;
        for (int t = 0; t < nt; t += 2) {
            const bool last = (t == nt - 2);
            const char* a1 = cA + (size_t)(t + 1) * kstep;
            const char* a2 = last ? nA : cA + (size_t)(t + 2) * kstep; const char* b2 = last ? nB : cB + (size_t)(t + 2) * kstep;
            const char* a3 = a2 + kstep; const char* b3 = b2 + kstep;
            if (last && has_next) S.a_ready(nxt);
            if constexpr (SP2) {
            PG8_LDB(B0, 0, 0); PG8_LDB(B1, 0, 1); PG8_SCHED; PG8_LDA(At, 0, 0); PG8_STAGE(PG8_SA(1, 1), a1 + hstep, voffA);
            PG8_WAIT_V(8); PG8_WAIT_L(0); PG8_BAR; PG8_MMA(0, 0, At, B0); PG8_MMA(0, 1, At, B1); PG8_BAR; PG8_SCHED;
            PG8_LDA(At, 0, 1); PG8_STAGE(PG8_SB(0, 0), b2, voffB); PG8_STAGE(PG8_SB(0, 1), b2 + hstep, voffB); PG8_STAGE(PG8_SA(0, 0), a2, voffA);
            PG8_WAIT_V(8); PG8_WAIT_L(0); PG8_BAR; PG8_MMA(1, 0, At, B0); PG8_MMA(1, 1, At, B1); PG8_BAR; PG8_SCHED;
            PG8_LDB(B0, 1, 0); PG8_LDB(B1, 1, 1); PG8_SCHED; PG8_LDA(At, 1, 0); PG8_STAGE(PG8_SA(0, 1), a2 + hstep, voffA);
            PG8_WAIT_V(8); PG8_WAIT_L(0); PG8_BAR; PG8_MMA(0, 0, At, B0); PG8_MMA(0, 1, At, B1); PG8_BAR; PG8_SCHED;
            PG8_LDA(At, 1, 1); PG8_STAGE(PG8_SB(1, 0), b3, voffB); PG8_STAGE(PG8_SB(1, 1), b3 + hstep, voffB); PG8_STAGE(PG8_SA(1, 0), a3, voffA);
            PG8_WAIT_V(8); PG8_WAIT_L(0); PG8_BAR; PG8_MMA(1, 0, At, B0); PG8_MMA(1, 1, At, B1); PG8_BAR; PG8_SCHED;
            } else {
            PG8_LDB(B0, 0, 0); PG8_SCHED; PG8_LDA(At, 0, 0); PG8_STAGE(PG8_SA(1, 1), a1 + hstep, voffA);
            PG8_WAIT_L(8); PG8_BAR; PG8_WAIT_L(0); PG8_MMA(0, 0, At, B0); PG8_BAR; PG8_SCHED;
            PG8_LDB(B1, 0, 1); PG8_STAGE(PG8_SB(0, 0), b2, voffB);
            PG8_BAR; PG8_WAIT_L(0); PG8_MMA(0, 1, At, B1); PG8_BAR;
            PG8_LDA(At, 0, 1); PG8_STAGE(PG8_SA(0, 0), a2, voffA);
            PG8_BAR; PG8_WAIT_L(0); PG8_MMA(1, 0, At, B0); PG8_BAR; PG8_SCHED;
            PG8_STAGE(PG8_SB(0, 1), b2 + hstep, voffB);
            PG8_WAIT_V(6); PG8_BAR; PG8_MMA(1, 1, At, B1); PG8_BAR;
            PG8_LDB(B0, 1, 0); PG8_SCHED; PG8_LDA(At, 1, 0); PG8_STAGE(PG8_SA(0, 1), a2 + hstep, voffA);
            PG8_WAIT_L(8); PG8_BAR; PG8_WAIT_L(0); PG8_MMA(0, 0, At, B0); PG8_BAR; PG8_SCHED;
            PG8_LDB(B1, 1, 1); PG8_STAGE(PG8_SB(1, 0), b3, voffB);
            PG8_BAR; PG8_WAIT_L(0); PG8_MMA(0, 1, At, B1); PG8_BAR;
            PG8_LDA(At, 1, 1); PG8_STAGE(PG8_SA(1, 0), a3, voffA);
            PG8_BAR; PG8_WAIT_L(0); PG8_MMA(1, 0, At, B0); PG8_BAR; PG8_SCHED;
            PG8_STAGE(PG8_SB(1, 1), b3 + hstep, voffB);
            PG8_WAIT_V(6); PG8_BAR; PG8_MMA(1, 1, At, B1); PG8_BAR;
            }
        }
        if constexpr (ALIGN_EPI) { if (wr == 0) PG8_BAR; }
        if constexpr (!Epi::AFTER_DRAIN) { E(acc, cur, wr, wc, fr, fq); S.done(cur); }
        if (!has_next) break;
#pragma unroll
        for (int a = 0; a < 2; ++a)
#pragma unroll
            for (int b = 0; b < 2; ++b)
#pragma unroll
                for (int m = 0; m < 4; ++m)
#pragma unroll
                    for (int n = 0; n < 2; ++n) acc[a][b][m][n] = (f32x4){0.f, 0.f, 0.f, 0.f};
        cur = nxt; cA = nA; cB = nB; ++ui;
        if constexpr (ALIGN_EPI) { if (wr == 1) PG8_BAR; }
    }
    PG8_WAIT_V(0);
    if constexpr (!ALIGN_EPI) { if (wr == 0) PG8_BAR; }
    PG8_BAR;
    if constexpr (Epi::AFTER_DRAIN) { E.fused(acc, cur, wr, wc, fr, fq, lds, wid, lane); S.done(cur); }
#undef PG8_SA
#undef PG8_SB
#undef PG8_STAGE
#undef PG8_LDA
#undef PG8_LDB
#undef PG8_MMA
#undef PG8_WAIT_V
#undef PG8_WAIT_L
#undef PG8_BAR
#undef PG8_SCHED
}
}

#define LAS __attribute__((address_space(3)))
typedef unsigned short bf16_t;
typedef short bf16x8 __attribute__((ext_vector_type(8)));
typedef float f32x4 __attribute__((ext_vector_type(4)));
typedef float f32x16 __attribute__((ext_vector_type(16)));
typedef unsigned u32x4 __attribute__((ext_vector_type(4)));
typedef unsigned u32x2 __attribute__((ext_vector_type(2)));

constexpr int BATCH = 4, SEQ = 8192, DM = 1024, DFF = 2816, T = BATCH * SEQ;
constexpr float EPS = 1e-6f;
constexpr float LOG2E = 1.4426950408889634f;
constexpr size_t MiB = 1u << 20;
constexpr size_t WS_R1 = 0;
constexpr size_t WS_R2 = 192 * MiB;
constexpr size_t WS_R3 = 256 * MiB;
constexpr size_t WS_R5 = 320 * MiB;
constexpr size_t WS_W = 448 * MiB;
constexpr size_t WO_GU0 = 0, WO_D0 = 11 * MiB, WO_GU1 = 17 * MiB, WO_D1 = 28 * MiB, WO_IN = 34 * MiB, WO_OUT = 40 * MiB;
constexpr size_t WS_END = 492 * MiB;
constexpr int LDS_BYTES = 135168;

struct Params {
    const float* x; const float* norm_g;
    const float* ffn_wg[2]; const float* ffn_wu[2]; const float* ffn_wd[2];
    const float* diff_w_in; const float* diff_w_out; const float* diff_lambda; const float* diff_subln;
    const float* na_w_in; const float* na_w_out; const float* na_rpb;
    const float* gqa_w_in; const float* gqa_w_out; const float* gqa_qk_norm;
    float* out; unsigned char* ws;
    float inv_a[8]; float inv_c[16];
};

typedef const __attribute__((address_space(4))) Params* KP;
__device__ __forceinline__ KP kparams() { KP k = (KP)__builtin_amdgcn_kernarg_segment_ptr(); asm volatile("" : "+s"(k)); return k; }
struct Ids { int tid, lane, wave, vcu, G, bx, gw, NGW, gtid, NTH; };
__device__ __forceinline__ Ids ids() {
    Ids I; int t = threadIdx.x; asm volatile("" : "+v"(t)); int b = blockIdx.x; asm volatile("" : "+s"(b));
    I.tid = t; I.lane = t & 63; I.wave = __builtin_amdgcn_readfirstlane(t >> 6); I.G = gridDim.x; I.bx = b;
    I.vcu = (I.G % 8 == 0) ? (b % 8) * (I.G / 8) + b / 8 : b;
    I.gw = I.vcu * 8 + I.wave; I.NGW = I.G * 8; I.gtid = I.vcu * 512 + t; I.NTH = I.G * 512; return I;
}
__device__ __forceinline__ unsigned f2bf(float f) { unsigned u = __builtin_bit_cast(unsigned, f); return (u + 0x7fffu + ((u >> 16) & 1u)) >> 16; }
__device__ __forceinline__ unsigned pk2(float lo, float hi) { return f2bf(lo) | (f2bf(hi) << 16); }
__device__ __forceinline__ float bflo(unsigned w) { return __builtin_bit_cast(float, w << 16); }
__device__ __forceinline__ float bfhi(unsigned w) { return __builtin_bit_cast(float, w & 0xffff0000u); }
__device__ __forceinline__ float wave_sum(float v) {
#pragma unroll
    for (int o = 1; o < 64; o <<= 1) v += __shfl_xor(v, o);
    return v;
}
__device__ __forceinline__ void sincos_rr(float ang, float& s, float& c) {
    double rev = (double)ang * 0.15915494309189535; rev -= __builtin_floor(rev);
    const float fr = (float)rev;
    s = __builtin_amdgcn_sinf(fr); c = __builtin_amdgcn_cosf(fr);
}

__device__ __forceinline__ void transpose_item(const float* __restrict__ W, int K, int N, bf16_t* __restrict__ WT, int k0, int n0, int orow0, LAS float* scr, int lane) {
#pragma unroll 8
    for (int i = 0; i < 32; ++i) { const int kk = 2 * i + (lane >> 5); scr[kk * 33 + (lane & 31)] = W[(size_t)(k0 + kk) * N + n0 + (lane & 31)]; }
    asm volatile("s_waitcnt lgkmcnt(0)" ::: "memory");
    const int c = lane & 7;
#pragma unroll
    for (int j = 0; j < 4; ++j) { const int n = (lane >> 3) + 8 * j; const LAS float* s = scr + (8 * c) * 33 + n;
        u32x4 o; o.x = pk2(s[0 * 33], s[1 * 33]); o.y = pk2(s[2 * 33], s[3 * 33]); o.z = pk2(s[4 * 33], s[5 * 33]); o.w = pk2(s[6 * 33], s[7 * 33]);
        *(u32x4*)(WT + (size_t)(orow0 + n) * K + k0 + 8 * c) = o; }
    asm volatile("s_waitcnt lgkmcnt(0)" ::: "memory");
}
__device__ __forceinline__ void phase_convert(int layer, LAS unsigned char* lds) {
    layer = __builtin_amdgcn_readfirstlane(layer); asm volatile("" : "+s"(layer));
    const KP kp = kparams(); const Ids I = ids(); const int gw = I.gw, NGW = I.NGW, wave = I.wave, lane = I.lane;
    LAS float* scr = (LAS float*)(lds + wave * 16384);
    unsigned char* wsw = kp->ws + WS_W;
    const int kind = layer % 3, jj = layer / 3;
    const float* w_in; const float* w_out; int Nin;
    if (kind == 0) { w_in = kp->diff_w_in + (size_t)jj * DM * 3072; w_out = kp->diff_w_out + (size_t)jj * DM * DM; Nin = 3072; }
    else if (kind == 1) { w_in = kp->na_w_in + (size_t)jj * DM * 3072; w_out = kp->na_w_out + (size_t)jj * DM * DM; Nin = 3072; }
    else { w_in = kp->gqa_w_in + (size_t)jj * DM * 1536; w_out = kp->gqa_w_out + (size_t)jj * DM * DM; Nin = 1536; }
    constexpr int I_GU = (DM / 64) * (DFF / 32), I_D = (DFF / 64) * (DM / 32), I_OUT = (DM / 64) * (DM / 32);
    const int I_IN = (DM / 64) * (Nin / 32);
    const int total = 2 * (2 * I_GU + I_D) + I_IN + I_OUT;
    const size_t lofs = (size_t)layer * DM * DFF;
    for (int it = gw; it < total; it += NGW) {
        int r = it;
        if (r < 2 * (2 * I_GU + I_D)) {
            const int f = r / (2 * I_GU + I_D); r -= f * (2 * I_GU + I_D);
            bf16_t* gu = (bf16_t*)(wsw + (f ? WO_GU1 : WO_GU0)); bf16_t* wd = (bf16_t*)(wsw + (f ? WO_D1 : WO_D0));
            if (r < 2 * I_GU) {
                const int up = r / I_GU; r -= up * I_GU;
                const float* W = (up ? kp->ffn_wu[f] : kp->ffn_wg[f]) + lofs;
                const int nblk = DFF / 32, kb = r / nblk, nb = r % nblk, n0 = 32 * nb;
                transpose_item(W, DM, DFF, gu, 64 * kb, n0, 256 * (n0 / 128) + (n0 % 128) + 128 * up, scr, lane);
            } else {
                r -= 2 * I_GU;
                const int nblk = DM / 32, kb = r / nblk, nb = r % nblk, n0 = 32 * nb;
                transpose_item(kp->ffn_wd[f] + lofs, DFF, DM, wd, 64 * kb, n0, n0, scr, lane);
            }
        } else {
            r -= 2 * (2 * I_GU + I_D);
            if (r < I_IN) { const int nblk = Nin / 32, kb = r / nblk, nb = r % nblk, n0 = 32 * nb;
                transpose_item(w_in, DM, Nin, (bf16_t*)(wsw + WO_IN), 64 * kb, n0, n0, scr, lane); }
            else { r -= I_IN; const int nblk = DM / 32, kb = r / nblk, nb = r % nblk, n0 = 32 * nb;
                transpose_item(w_out, DM, DM, (bf16_t*)(wsw + WO_OUT), 64 * kb, n0, n0, scr, lane); }
        }
    }
}

__device__ __forceinline__ void phase_init_rows() {
    const KP kp = kparams(); const Ids I = ids(); const int gw = I.gw, NGW = I.NGW, lane = I.lane;
    const float* __restrict__ x = kp->x; float* __restrict__ h = kp->out; bf16_t* __restrict__ xn = (bf16_t*)(kp->ws + WS_R2); const float* __restrict__ g_pre = kp->norm_g;
    for (int row = gw; row < T; row += NGW) {
        const f32x4* xr = (const f32x4*)(x + (size_t)row * DM) + lane;
        f32x4 v[4]; float ss = 0.f;
#pragma unroll
        for (int j = 0; j < 4; ++j) { v[j] = xr[64 * j]; ss += (v[j].x * v[j].x + v[j].y * v[j].y) + (v[j].z * v[j].z + v[j].w * v[j].w); }
        const float rstd = 1.0f / sqrtf(wave_sum(ss) * (1.0f / DM) + EPS);
        f32x4* hr = (f32x4*)(h + (size_t)row * DM) + lane;
        u32x2* o8 = (u32x2*)(xn + (size_t)row * DM) + lane;
#pragma unroll
        for (int j = 0; j < 4; ++j) { hr[64 * j] = v[j]; const f32x4 g = ((const f32x4*)g_pre)[lane + 64 * j];
            u32x2 w; w.x = pk2(v[j].x * rstd * g.x, v[j].y * rstd * g.y); w.y = pk2(v[j].z * rstd * g.z, v[j].w * rstd * g.w); o8[64 * j] = w; }
    }
}
__device__ __forceinline__ void phase_rowwise(int layer, int sub) {
    layer = __builtin_amdgcn_readfirstlane(layer); sub = __builtin_amdgcn_readfirstlane(sub); asm volatile("" : "+s"(layer), "+s"(sub));
    const KP kp = kparams(); const Ids I = ids(); const int gw = I.gw, NGW = I.NGW, lane = I.lane;
    float* __restrict__ h = kp->out; const bf16_t* __restrict__ y = (const bf16_t*)(kp->ws + WS_R3); bf16_t* __restrict__ xn = (bf16_t*)(kp->ws + WS_R2);
    const float* gl = kp->norm_g + (size_t)layer * 6 * DM;
    const float coef = (sub == 1) ? 1.0f : 0.5f;
    const float* __restrict__ g_post = gl + (size_t)(2 * sub + 1) * DM;
    const float* __restrict__ g_pre = (sub < 2) ? gl + (size_t)(2 * sub + 2) * DM : (layer < 3 ? gl + (size_t)6 * DM : nullptr);
    for (int row = gw; row < T; row += NGW) {
        f32x4* hr = (f32x4*)(h + (size_t)row * DM) + lane;
        const u32x2* yr = (const u32x2*)(y + (size_t)row * DM) + lane;
        f32x4 hv[4], yv[4]; float ss = 0.f;
#pragma unroll
        for (int j = 0; j < 4; ++j) { hv[j] = hr[64 * j]; const u32x2 w = yr[64 * j]; yv[j] = (f32x4){bflo(w.x), bfhi(w.x), bflo(w.y), bfhi(w.y)};
            ss += (yv[j].x * yv[j].x + yv[j].y * yv[j].y) + (yv[j].z * yv[j].z + yv[j].w * yv[j].w); }
        const float rs = coef / sqrtf(wave_sum(ss) * (1.0f / DM) + EPS);
        float s2 = 0.f;
#pragma unroll
        for (int j = 0; j < 4; ++j) { const f32x4 g = ((const f32x4*)g_post)[lane + 64 * j];
            hv[j].x += yv[j].x * rs * g.x; hv[j].y += yv[j].y * rs * g.y; hv[j].z += yv[j].z * rs * g.z; hv[j].w += yv[j].w * rs * g.w;
            hr[64 * j] = hv[j];
            s2 += (hv[j].x * hv[j].x + hv[j].y * hv[j].y) + (hv[j].z * hv[j].z + hv[j].w * hv[j].w); }
        if (g_pre) {
            const float rstd = 1.0f / sqrtf(wave_sum(s2) * (1.0f / DM) + EPS);
            u32x2* o8 = (u32x2*)(xn + (size_t)row * DM) + lane;
#pragma unroll
            for (int j = 0; j < 4; ++j) { const f32x4 g = ((const f32x4*)g_pre)[lane + 64 * j];
                u32x2 w; w.x = pk2(hv[j].x * rstd * g.x, hv[j].y * rstd * g.y); w.y = pk2(hv[j].z * rstd * g.z, hv[j].w * rstd * g.w); o8[64 * j] = w; }
        }
    }
}

__device__ __forceinline__ void phase_post_a() {
    const KP kp = kparams(); const Ids I = ids(); const int gtid = I.gtid, NTH = I.NTH;
    bf16_t* raw = (bf16_t*)(kp->ws + WS_R1);
    float inv[8];
#pragma unroll
    for (int j = 0; j < 8; ++j) inv[j] = kp->inv_a[j];
    for (int item = gtid; item < T * 16; item += NTH) {
        const int t = item >> 4, w = item & 15;
        bf16_t* ptr = raw + (size_t)t * 3072 + w * 64;
        const u32x4 a = *(const u32x4*)ptr, b = *(const u32x4*)(ptr + 8);
        float x1[8] = {bflo(a.x), bfhi(a.x), bflo(a.y), bfhi(a.y), bflo(a.z), bfhi(a.z), bflo(a.w), bfhi(a.w)};
        float x2[8] = {bflo(b.x), bfhi(b.x), bflo(b.y), bfhi(b.y), bflo(b.z), bfhi(b.z), bflo(b.w), bfhi(b.w)};
        const float pos = (float)(t & (SEQ - 1));
        float y1[8], y2[8];
#pragma unroll
        for (int j = 0; j < 8; ++j) { float s, c; sincos_rr(pos * inv[j], s, c); y1[j] = x1[j] * c - x2[j] * s; y2[j] = x2[j] * c + x1[j] * s; }
        u32x4 oa, ob;
        oa.x = pk2(y1[0], y1[1]); oa.y = pk2(y1[2], y1[3]); oa.z = pk2(y1[4], y1[5]); oa.w = pk2(y1[6], y1[7]);
        ob.x = pk2(y2[0], y2[1]); ob.y = pk2(y2[2], y2[3]); ob.z = pk2(y2[4], y2[5]); ob.w = pk2(y2[6], y2[7]);
        *(u32x4*)ptr = oa; *(u32x4*)(ptr + 8) = ob;
    }
}
__device__ __forceinline__ void phase_post_c(int jj) {
    const KP kp = kparams(); const Ids I = ids(); const int gtid = I.gtid, NTH = I.NTH;
    bf16_t* raw = (bf16_t*)(kp->ws + WS_R1); const float* __restrict__ qk_g = kp->gqa_qk_norm + (size_t)jj * 128;
    float inv[16];
#pragma unroll
    for (int j = 0; j < 16; ++j) inv[j] = kp->inv_c[j];
    for (int item = gtid; item < T * 16; item += NTH) {
        const int t = item >> 4, hd = item & 15;
        bf16_t* ptr = raw + (size_t)t * 1536 + hd * 64;
        const float* g = qk_g;
        float x[64]; float ss = 0.f;
#pragma unroll
        for (int i = 0; i < 8; ++i) { const u32x4 a = *(const u32x4*)(ptr + 8 * i);
            x[8 * i + 0] = bflo(a.x); x[8 * i + 1] = bfhi(a.x); x[8 * i + 2] = bflo(a.y); x[8 * i + 3] = bfhi(a.y);
            x[8 * i + 4] = bflo(a.z); x[8 * i + 5] = bfhi(a.z); x[8 * i + 6] = bflo(a.w); x[8 * i + 7] = bfhi(a.w); }
#pragma unroll
        for (int i = 0; i < 64; ++i) ss += x[i] * x[i];
        const float rstd = 1.0f / sqrtf(ss * (1.0f / 64.0f) + EPS);
        const float rq = rstd * (0.125f * LOG2E);
#pragma unroll
        for (int i = 0; i < 64; ++i) x[i] = x[i] * rq * g[i];
        const int s_idx = t & (SEQ - 1);
        const float pr = (float)(s_idx >> 6), pc = (float)(s_idx & 63);
#pragma unroll
        for (int j = 0; j < 16; ++j) {
            float s, c; sincos_rr(pr * inv[j], s, c);
            const float a1 = x[j], a2 = x[j + 16]; x[j] = a1 * c - a2 * s; x[j + 16] = a2 * c + a1 * s;
            sincos_rr(pc * inv[j], s, c);
            const float b1 = x[32 + j], b2 = x[48 + j]; x[32 + j] = b1 * c - b2 * s; x[48 + j] = b2 * c + b1 * s;
        }
#pragma unroll
        for (int i = 0; i < 8; ++i) { u32x4 o; o.x = pk2(x[8 * i], x[8 * i + 1]); o.y = pk2(x[8 * i + 2], x[8 * i + 3]); o.z = pk2(x[8 * i + 4], x[8 * i + 5]); o.w = pk2(x[8 * i + 6], x[8 * i + 7]);
            *(u32x4*)(ptr + 8 * i) = o; }
    }
}
template <int KIND>
__device__ __forceinline__ void phase_kpack(int jj) {
    jj = __builtin_amdgcn_readfirstlane(jj); asm volatile("" : "+s"(jj));
    const KP kp = kparams(); const Ids I = ids(); const int gw = I.gw, NGW = I.NGW, lane = I.lane;
    constexpr int LD = (KIND == 2) ? 1536 : 3072, NKH = (KIND == 2) ? 4 : 16;
    const bf16_t* __restrict__ raw = (const bf16_t*)(kp->ws + WS_R1); bf16_t* __restrict__ Kt = (bf16_t*)(kp->ws + WS_R2);
    float inv[16];
#pragma unroll
    for (int j = 0; j < 16; ++j) inv[j] = (KIND == 0) ? kp->inv_a[j & 7] : kp->inv_c[j];
    const float* __restrict__ g = kp->gqa_qk_norm + (size_t)jj * 128 + 64;
    for (int it = gw; it < (T / 64) * NKH; it += NGW) {
        const int tt = it / NKH, hd = it - tt * NKH;
        const int t = tt * 64 + lane, b = t / SEQ, s_idx = t - b * SEQ;
        const bf16_t* src = raw + (size_t)t * LD + 1024 + hd * 64;
        float x[64];
#pragma unroll
        for (int i = 0; i < 8; ++i) { const u32x4 a = *(const u32x4*)(src + 8 * i);
            x[8 * i + 0] = bflo(a.x); x[8 * i + 1] = bfhi(a.x); x[8 * i + 2] = bflo(a.y); x[8 * i + 3] = bfhi(a.y);
            x[8 * i + 4] = bflo(a.z); x[8 * i + 5] = bfhi(a.z); x[8 * i + 6] = bflo(a.w); x[8 * i + 7] = bfhi(a.w); }
        if (KIND == 0) {
            const float pos = (float)s_idx;
#pragma unroll
            for (int j = 0; j < 8; ++j) { float s, c; sincos_rr(pos * inv[j], s, c); const float a1 = x[j], a2 = x[j + 8]; x[j] = a1 * c - a2 * s; x[j + 8] = a2 * c + a1 * s; }
        }
        if (KIND == 2) {
            float ss = 0.f;
#pragma unroll
            for (int i = 0; i < 64; ++i) ss += x[i] * x[i];
            const float rstd = 1.0f / sqrtf(ss * (1.0f / 64.0f) + EPS);
#pragma unroll
            for (int i = 0; i < 64; ++i) x[i] = x[i] * rstd * g[i];
            const float pr = (float)(s_idx >> 6), pc = (float)(s_idx & 63);
#pragma unroll
            for (int j = 0; j < 16; ++j) {
                float s, c; sincos_rr(pr * inv[j], s, c);
                const float a1 = x[j], a2 = x[j + 16]; x[j] = a1 * c - a2 * s; x[j + 16] = a2 * c + a1 * s;
                sincos_rr(pc * inv[j], s, c);
                const float b1 = x[32 + j], b2 = x[48 + j]; x[32 + j] = b1 * c - b2 * s; x[48 + j] = b2 * c + b1 * s;
            }
        }
        bf16_t* dst = Kt + (((size_t)(b * NKH + hd) * (SEQ / 64) + (s_idx >> 6)) * 64 + (s_idx & 63)) * 64;
#pragma unroll
        for (int i = 0; i < 8; ++i) { u32x4 o; o.x = pk2(x[8 * i], x[8 * i + 1]); o.y = pk2(x[8 * i + 2], x[8 * i + 3]); o.z = pk2(x[8 * i + 4], x[8 * i + 5]); o.w = pk2(x[8 * i + 6], x[8 * i + 7]);
            *(u32x4*)(dst + 8 * i) = o; }
    }
}
__device__ __forceinline__ void phase_vt(int ld, int voff, int VW, int DV, LAS unsigned char* lds) {
    const KP kp = kparams(); const Ids I = ids(); const int tid = I.tid, vcu = I.vcu, G = I.G;
    const bf16_t* __restrict__ raw = (const bf16_t*)(kp->ws + WS_R1); bf16_t* __restrict__ Vt = (bf16_t*)(kp->ws + WS_R3);
    const int ncb = VW / 256, ntiles = (T / 64) * ncb;
    for (int tile = vcu; tile < ntiles; tile += G) {
        const int tm = tile / ncb, cb = tile - tm * ncb;
        const int tok0 = tm * 64, b = tok0 / SEQ, s0 = tok0 - b * SEQ;
        { const int tok = tid >> 3, c8 = tid & 7;
          const bf16_t* src = raw + (size_t)(tok0 + tok) * ld + voff + cb * 256;
#pragma unroll
          for (int i = 0; i < 4; ++i) { const int ch = c8 + 8 * i; const u32x4 v = *(const u32x4*)(src + ch * 8); *(LAS u32x4*)(lds + tok * 528 + ch * 16) = v; } }
        __syncthreads();
        { const int col = tid >> 1, half = tid & 1;
          unsigned w[16];
#pragma unroll
          for (int i = 0; i < 16; ++i) { const unsigned lo = *(const LAS unsigned short*)(lds + (32 * half + 2 * i) * 528 + col * 2);
              const unsigned hi = *(const LAS unsigned short*)(lds + (32 * half + 2 * i + 1) * 528 + col * 2); w[i] = lo | (hi << 16); }
          const int cc = cb * 256 + col, vh = cc / DV, d = cc - vh * DV;
          bf16_t* dst = Vt + ((((size_t)b * (VW / DV) + vh) * (SEQ / 64) + (s0 >> 6)) * DV + d) * 64 + 32 * half;
#pragma unroll
          for (int i = 0; i < 4; ++i) { u32x4 o; o.x = w[4 * i]; o.y = w[4 * i + 1]; o.z = w[4 * i + 2]; o.w = w[4 * i + 3]; *(u32x4*)(dst + 8 * i) = o; } }
        __syncthreads();
    }
}
__device__ __forceinline__ void phase_subln(int layer, int jj) {
    layer = __builtin_amdgcn_readfirstlane(layer); jj = __builtin_amdgcn_readfirstlane(jj); asm volatile("" : "+s"(layer), "+s"(jj));
    const KP kp = kparams(); const Ids I = ids(); const int gw = I.gw, NGW = I.NGW, lane = I.lane;
    const bf16_t* __restrict__ Opart = (const bf16_t*)(kp->ws + WS_R5); bf16_t* __restrict__ xo = (bf16_t*)(kp->ws + WS_R2);
    const float* __restrict__ lamv = kp->diff_lambda + (size_t)jj * 256; const float* __restrict__ subg = kp->diff_subln + (size_t)jj * 128;
    const float lam_init = 0.8f - 0.6f * expf(-0.3f * (float)layer);
    const float d1 = wave_sum(lamv[lane] * lamv[64 + lane]), d2 = wave_sum(lamv[128 + lane] * lamv[192 + lane]);
    const float lam = expf(d1) - expf(d2) + lam_init;
    const float osc = 1.0f - lam_init;
    const int sub = lane & 15;
    float g[8];
#pragma unroll
    for (int i = 0; i < 8; ++i) g[i] = subg[8 * sub + i] * osc;
    for (int it = gw; it < T * 2; it += NGW) {
        const int item = it * 4 + (lane >> 4); const int t = item >> 3, hd = item & 7;
        const bf16_t* src = Opart + (size_t)t * 2048 + hd * 256 + 8 * sub;
        const u32x4 a = *(const u32x4*)src, b = *(const u32x4*)(src + 128);
        float o[8];
        o[0] = bflo(a.x) - lam * bflo(b.x); o[1] = bfhi(a.x) - lam * bfhi(b.x); o[2] = bflo(a.y) - lam * bflo(b.y); o[3] = bfhi(a.y) - lam * bfhi(b.y);
        o[4] = bflo(a.z) - lam * bflo(b.z); o[5] = bfhi(a.z) - lam * bfhi(b.z); o[6] = bflo(a.w) - lam * bflo(b.w); o[7] = bfhi(a.w) - lam * bfhi(b.w);
        float ss = 0.f;
#pragma unroll
        for (int i = 0; i < 8; ++i) ss += o[i] * o[i];
        ss += __shfl_xor(ss, 1); ss += __shfl_xor(ss, 2); ss += __shfl_xor(ss, 4); ss += __shfl_xor(ss, 8);
        const float rstd = 1.0f / sqrtf(ss * (1.0f / 128.0f) + EPS);
        u32x4 w; w.x = pk2(o[0] * rstd * g[0], o[1] * rstd * g[1]); w.y = pk2(o[2] * rstd * g[2], o[3] * rstd * g[3]);
        w.z = pk2(o[4] * rstd * g[4], o[5] * rstd * g[5]); w.w = pk2(o[6] * rstd * g[6], o[7] * rstd * g[7]);
        *(u32x4*)(xo + (size_t)t * DM + hd * 128 + 8 * sub) = w;
    }
}

__device__ __forceinline__ unsigned cvtpk(float lo, float hi) { unsigned r; asm volatile("v_cvt_pk_bf16_f32 %0, %1, %2" : "=v"(r) : "v"(lo), "v"(hi)); return r; }
template <int DV, int MODE>
__device__ __forceinline__ void attn_unit(LAS unsigned char* lds, const bf16_t* __restrict__ Qp, int ldq, const bf16_t* __restrict__ Kp, int ldk,
                                          const bf16_t* __restrict__ Vp, bf16_t* __restrict__ Op, int ldo, int t_lo, int t_hi, const float* __restrict__ rpb_h, int r4, int tid) {
    constexpr int KROW = 144, KB_BYTES = 64 * KROW, VB_BYTES = DV * KROW, BUF = KB_BYTES + VB_BYTES, NDB = DV / 32, NVP = DV / 64;
    constexpr float cscale = 1.0f;
    const int lane = tid & 63, wid = __builtin_amdgcn_readfirstlane(tid >> 6), j = lane & 31, hi = lane >> 5;
    bf16x8 qf[4];
    { const bf16_t* qrow = Qp + (size_t)(wid * 32 + j) * ldq + hi * 8;
#pragma unroll
      for (int d0 = 0; d0 < 4; ++d0) qf[d0] = *(const bf16x8*)(qrow + d0 * 16); }
    const int srow = tid >> 3, sch = tid & 7;
    const bf16_t* kg = Kp + tid * 8;
    const bf16_t* vg = Vp + tid * 8;
    const int ks_off = srow * KROW + sch * 16;
    const int kap = (j & 0x13) | ((j & 4) << 1) | ((j & 8) >> 1);
    const int kr_off = kap * KROW + hi * 16;
    const int vr_off = KB_BYTES + j * KROW + hi * 16;
    LAS float* rp = (LAS float*)(lds + 2 * BUF);
    int qr = 0, qc = 0, r0 = 0, cs = 0;
    if (MODE == 1) {
        qr = r4 + (wid >> 1); qc = (wid & 1) * 32 + j;
        r0 = qr - 4; r0 = r0 < 0 ? 0 : (r0 > 120 ? 120 : r0);
        cs = qc - 8; cs = cs < 0 ? 0 : (cs > 48 ? 48 : cs);
        for (int i = tid; i < 15 * 31; i += 512) rp[i] = rpb_h[i] * LOG2E;
    }
    u32x4 kreg, vreg[NVP];
    kreg = *(const u32x4*)(kg + (size_t)t_lo * 4096);
#pragma unroll
    for (int pt = 0; pt < NVP; ++pt) vreg[pt] = *(const u32x4*)(vg + (size_t)t_lo * (DV * 64) + pt * 4096);
    *(LAS u32x4*)(lds + ks_off) = kreg;
#pragma unroll
    for (int pt = 0; pt < NVP; ++pt) *(LAS u32x4*)(lds + KB_BYTES + pt * 64 * KROW + ks_off) = vreg[pt];
    __syncthreads();
    float m_run = -INFINITY, l_run = 0.f;
    f32x16 o[NDB];
#pragma unroll
    for (int db = 0; db < NDB; ++db)
#pragma unroll
        for (int r = 0; r < 16; ++r) o[db][r] = 0.f;
    for (int t = t_lo; t < t_hi; ++t) {
        const int bufoff = ((t - t_lo) & 1) * BUF;
        const bool more = (t + 1 < t_hi);
        if (more) {
            kreg = *(const u32x4*)(kg + (size_t)(t + 1) * 4096);
#pragma unroll
            for (int pt = 0; pt < NVP; ++pt) vreg[pt] = *(const u32x4*)(vg + (size_t)(t + 1) * (DV * 64) + pt * 4096);
        }
        bool active = true;
        if (MODE == 1) active = (t >= r0) && (t < r0 + 8);
        if (active) {
            f32x16 s0, s1;
#pragma unroll
            for (int r = 0; r < 16; ++r) { s0[r] = 0.f; s1[r] = 0.f; }
#pragma unroll
            for (int d0 = 0; d0 < 4; ++d0) {
                const bf16x8 k0 = *(const LAS bf16x8*)(lds + bufoff + kr_off + d0 * 32);
                const bf16x8 k1 = *(const LAS bf16x8*)(lds + bufoff + kr_off + 32 * KROW + d0 * 32);
                s0 = __builtin_amdgcn_mfma_f32_32x32x16_bf16(k0, qf[d0], s0, 0, 0, 0);
                s1 = __builtin_amdgcn_mfma_f32_32x32x16_bf16(k1, qf[d0], s1, 0, 0, 0);
            }
            if (MODE == 1) {
                const int dr = t - qr + 7;
#pragma unroll
                for (int r = 0; r < 16; ++r) {
                    { const int kc = 16 * (r >> 3) + 8 * hi + (r & 7); const bool ok = (kc >= cs) && (kc < cs + 16);
                      const float bias = rp[ok ? dr * 31 + (kc - qc + 15) : 0]; s0[r] = ok ? __builtin_fmaf(s0[r], cscale, bias) : -INFINITY; }
                    { const int kc = 32 + 16 * (r >> 3) + 8 * hi + (r & 7); const bool ok = (kc >= cs) && (kc < cs + 16);
                      const float bias = rp[ok ? dr * 31 + (kc - qc + 15) : 0]; s1[r] = ok ? __builtin_fmaf(s1[r], cscale, bias) : -INFINITY; }
                }
            }
            constexpr float sc = (MODE == 1) ? 1.0f : cscale;
            float mx = fmaxf(s0[0], s1[0]);
#pragma unroll
            for (int r = 1; r < 16; ++r) mx = fmaxf(mx, fmaxf(s0[r], s1[r]));
            mx = fmaxf(mx, __shfl_xor(mx, 32));
            const float m_new = fmaxf(m_run, mx * sc);
            const float alpha = __builtin_amdgcn_exp2f(m_run - m_new);
            m_run = m_new;
            float ls = 0.f;
#pragma unroll
            for (int r = 0; r < 16; ++r) { s0[r] = __builtin_amdgcn_exp2f(__builtin_fmaf(s0[r], sc, -m_new)); s1[r] = __builtin_amdgcn_exp2f(__builtin_fmaf(s1[r], sc, -m_new)); ls += s0[r] + s1[r]; }
            l_run = l_run * alpha + ls;
#pragma unroll
            for (int db = 0; db < NDB; ++db)
#pragma unroll
                for (int r = 0; r < 16; ++r) o[db][r] *= alpha;
            bf16x8 pf[2][2];
#pragma unroll
            for (int c = 0; c < 2; ++c) {
                u32x4 w0, w1;
                w0.x = cvtpk(s0[8 * c + 0], s0[8 * c + 1]); w0.y = cvtpk(s0[8 * c + 2], s0[8 * c + 3]); w0.z = cvtpk(s0[8 * c + 4], s0[8 * c + 5]); w0.w = cvtpk(s0[8 * c + 6], s0[8 * c + 7]);
                w1.x = cvtpk(s1[8 * c + 0], s1[8 * c + 1]); w1.y = cvtpk(s1[8 * c + 2], s1[8 * c + 3]); w1.z = cvtpk(s1[8 * c + 4], s1[8 * c + 5]); w1.w = cvtpk(s1[8 * c + 6], s1[8 * c + 7]);
                pf[0][c] = __builtin_bit_cast(bf16x8, w0); pf[1][c] = __builtin_bit_cast(bf16x8, w1);
            }
#pragma unroll
            for (int db = 0; db < NDB; ++db)
#pragma unroll
                for (int kb = 0; kb < 2; ++kb)
#pragma unroll
                    for (int c = 0; c < 2; ++c) {
                        const bf16x8 vf = *(const LAS bf16x8*)(lds + bufoff + vr_off + db * 32 * KROW + kb * 64 + c * 32);
                        o[db] = __builtin_amdgcn_mfma_f32_32x32x16_bf16(vf, pf[kb][c], o[db], 0, 0, 0);
                    }
        }
        if (more) {
            const int nb = BUF - bufoff;
            *(LAS u32x4*)(lds + nb + ks_off) = kreg;
#pragma unroll
            for (int pt = 0; pt < NVP; ++pt) *(LAS u32x4*)(lds + nb + KB_BYTES + pt * 64 * KROW + ks_off) = vreg[pt];
        }
        __syncthreads();
    }
    const float l_tot = l_run + __shfl_xor(l_run, 32);
    const float inv = 1.0f / l_tot;
    bf16_t* orow = Op + (size_t)(wid * 32 + j) * ldo + 4 * hi;
#pragma unroll
    for (int db = 0; db < NDB; ++db)
#pragma unroll
        for (int g = 0; g < 4; ++g) {
            u32x2 w; w.x = cvtpk(o[db][4 * g] * inv, o[db][4 * g + 1] * inv); w.y = cvtpk(o[db][4 * g + 2] * inv, o[db][4 * g + 3] * inv);
            *(u32x2*)(orow + 32 * db + 8 * g) = w;
        }
}
#define SB() __builtin_amdgcn_sched_barrier(0)
__device__ __forceinline__ float max3f(float a, float b, float c) { float r; asm("v_max3_f32 %0, %1, %2, %3" : "=v"(r) : "v"(a), "v"(b), "v"(c)); return r; }
__device__ __forceinline__ float xhalf_max(float m) { float a = m, b = m; asm volatile("s_nop 1\n\tv_permlane32_swap_b32 %0, %1\n\ts_nop 1" : "+v"(a), "+v"(b)); return max3f(a, b, b); }
__device__ __forceinline__ float xhalf_sum(float m) { float a = m, b = m; asm volatile("s_nop 1\n\tv_permlane32_swap_b32 %0, %1\n\ts_nop 1" : "+v"(a), "+v"(b)); return a + b; }
template <int DV>
__device__ __forceinline__ void attn_unit_dense(LAS unsigned char* lds, const bf16_t* __restrict__ Qp, int ldq, const bf16_t* __restrict__ Kp, int ldk,
                                                const bf16_t* __restrict__ Vp, bf16_t* __restrict__ Op, int ldo, int tid, int rot) {
    constexpr int KROW = 144, KB_BYTES = 64 * KROW, VB_BYTES = DV * KROW, NDB = DV / 32, NVP = DV / 64, NT = SEQ / 64;
    const int lane = tid & 63, wid = __builtin_amdgcn_readfirstlane(tid >> 6), j = lane & 31, hi = lane >> 5;
    bf16x8 qf[4];
    { const bf16_t* qrow = Qp + (size_t)(wid * 32 + j) * ldq + hi * 8;
#pragma unroll
      for (int d0 = 0; d0 < 4; ++d0) qf[d0] = *(const bf16x8*)(qrow + d0 * 16); }
    const int srow = tid >> 3, sch = tid & 7;
    const bf16_t* kg = Kp + tid * 8;
    const bf16_t* vg = Vp + tid * 8;
    const int ks_off = srow * KROW + sch * 16;
    const int kap = (j & 0x13) | ((j & 4) << 1) | ((j & 8) >> 1);
    const LAS unsigned char* kbase = lds + kap * KROW + hi * 16;
    const LAS unsigned char* vbase = lds + 2 * KB_BYTES + j * KROW + hi * 16;
    LAS unsigned char* kst = lds + ks_off;
    LAS unsigned char* vst = lds + 2 * KB_BYTES + ks_off;
    u32x4 kreg, vreg[NVP];
    kreg = *(const u32x4*)(kg + (size_t)(rot & (NT - 1)) * 4096);
#pragma unroll
    for (int pt = 0; pt < NVP; ++pt) vreg[pt] = *(const u32x4*)(vg + (size_t)(rot & (NT - 1)) * (DV * 64) + pt * 4096);
    *(LAS u32x4*)kst = kreg;
#pragma unroll
    for (int pt = 0; pt < NVP; ++pt) *(LAS u32x4*)(vst + pt * 64 * KROW) = vreg[pt];
    kreg = *(const u32x4*)(kg + (size_t)((rot + 1) & (NT - 1)) * 4096);
    *(LAS u32x4*)(kst + KB_BYTES) = kreg;
    __syncthreads();
    f32x16 S[2][2];
    f32x16 o[NDB];
#pragma unroll
    for (int db = 0; db < NDB; ++db)
#pragma unroll
        for (int r = 0; r < 16; ++r) o[db][r] = 0.f;
#pragma unroll
    for (int r = 0; r < 16; ++r) { S[0][0][r] = 0.f; S[0][1][r] = 0.f; }
#pragma unroll
    for (int d0 = 0; d0 < 4; ++d0) {
        const bf16x8 k0 = *(const LAS bf16x8*)(kbase + d0 * 32);
        const bf16x8 k1 = *(const LAS bf16x8*)(kbase + 32 * KROW + d0 * 32);
        S[0][0] = __builtin_amdgcn_mfma_f32_32x32x16_bf16(k0, qf[d0], S[0][0], 0, 0, 0);
        S[0][1] = __builtin_amdgcn_mfma_f32_32x32x16_bf16(k1, qf[d0], S[0][1], 0, 0, 0);
    }
    __syncthreads();
    float m_ref, l_run = 0.f;
    { float mx = fmaxf(S[0][0][0], S[0][1][0]);
#pragma unroll
      for (int r = 1; r < 16; ++r) mx = max3f(mx, S[0][0][r], S[0][1][r]);
      m_ref = xhalf_max(mx);
#pragma unroll
      for (int r = 0; r < 16; ++r) { S[0][0][r] = __builtin_amdgcn_exp2f(S[0][0][r] - m_ref); S[0][1][r] = __builtin_amdgcn_exp2f(S[0][1][r] - m_ref); } }
    for (int t = 0; t < NT; t += 2) {
#pragma unroll
        for (int u = 0; u < 2; ++u) {
            const int tt = t + u;
            const bool more1 = (tt + 1 < NT), more2 = (tt + 2 < NT);
            if (more2) kreg = *(const u32x4*)(kg + (size_t)((tt + 2 + rot) & (NT - 1)) * 4096);
            if (more1) {
#pragma unroll
                for (int pt = 0; pt < NVP; ++pt) vreg[pt] = *(const u32x4*)(vg + (size_t)((tt + 1 + rot) & (NT - 1)) * (DV * 64) + pt * 4096);
            }
            f32x16 (&Pc)[2] = S[u];
            f32x16 (&Sn)[2] = S[u ^ 1];
            const LAS unsigned char* kb_ = kbase + (u ^ 1) * KB_BYTES;
            const LAS unsigned char* vb_ = vbase + u * VB_BYTES;
            bf16x8 kf[8];
#pragma unroll
            for (int i = 0; i < 2; ++i) kf[i] = *(const LAS bf16x8*)(kb_ + (i & 1) * 32 * KROW + (i >> 1) * 32);
            SB();
            u32x4 pw[2][2];
            float sacc = 0.f;
#pragma unroll
            for (int g = 0; g < 8; ++g) {
                const int d0 = g >> 1, kb = g & 1;
                if (g + 2 < 8) { const int i = g + 2; kf[i] = *(const LAS bf16x8*)(kb_ + (i & 1) * 32 * KROW + (i >> 1) * 32); }
                if (d0 == 0) { f32x16 z;
#pragma unroll
                    for (int r = 0; r < 16; ++r) z[r] = 0.f;
                    Sn[kb] = __builtin_amdgcn_mfma_f32_32x32x16_bf16(kf[g], qf[0], z, 0, 0, 0); }
                else Sn[kb] = __builtin_amdgcn_mfma_f32_32x32x16_bf16(kf[g], qf[d0], Sn[kb], 0, 0, 0);
                { const int pk = g >> 2, r0 = 4 * (g & 3), c = (g & 3) >> 1, w = 2 * (g & 1);
                  sacc += Pc[pk][r0]; sacc += Pc[pk][r0 + 1]; sacc += Pc[pk][r0 + 2]; sacc += Pc[pk][r0 + 3];
                  pw[pk][c][w] = cvtpk(Pc[pk][r0], Pc[pk][r0 + 1]); pw[pk][c][w + 1] = cvtpk(Pc[pk][r0 + 2], Pc[pk][r0 + 3]);
                  asm volatile("" : "+v"(sacc)); }
                SB();
            }
            l_run += sacc;
            float mx = fmaxf(Sn[0][0], Sn[1][0]);
#pragma unroll
            for (int r = 1; r < 16; ++r) mx = max3f(mx, Sn[0][r], Sn[1][r]);
            mx = xhalf_max(mx);
            const float m_new = max3f(m_ref, mx, mx);
            const float fsc = __builtin_amdgcn_exp2f(m_ref - m_new);
            const bool grew = m_new > m_ref;
            m_ref = m_new; l_run *= fsc;
            asm volatile("" : "+v"(m_ref));
            SB();
            constexpr int NG = 4 * NDB;
            constexpr int EPG = 32 / NG;
            bf16x8 vf[NG];
#pragma unroll
            for (int i = 0; i < 2; ++i) vf[i] = *(const LAS bf16x8*)(vb_ + (i % NDB) * 32 * KROW + ((i / NDB) >> 1) * 64 + ((i / NDB) & 1) * 32);
            SB();
#pragma unroll
            for (int g = 0; g < NG; ++g) {
                if (g + 2 < NG) { const int i = g + 2; vf[i] = *(const LAS bf16x8*)(vb_ + (i % NDB) * 32 * KROW + ((i / NDB) >> 1) * 64 + ((i / NDB) & 1) * 32); }
                const int db = g % NDB, kc = g / NDB, kb = kc >> 1, c = kc & 1;
                o[db] = __builtin_amdgcn_mfma_f32_32x32x16_bf16(vf[g], __builtin_bit_cast(bf16x8, pw[kb][c]), o[db], 0, 0, 0);
#pragma unroll
                for (int e = 0; e < EPG; ++e) { const int idx = g * EPG + e, sk = idx >> 4, r = idx & 15;
                    float v = __builtin_amdgcn_exp2f(Sn[sk][r] - m_ref); asm volatile("" : "+v"(v)); Sn[sk][r] = v; }
                SB();
            }
            if (__any(grew)) {
#pragma unroll
                for (int db = 0; db < NDB; ++db)
#pragma unroll
                    for (int r = 0; r < 16; ++r) o[db][r] *= fsc;
            }
            if (more2) *(LAS u32x4*)(kst + u * KB_BYTES) = kreg;
            if (more1) {
#pragma unroll
                for (int pt = 0; pt < NVP; ++pt) *(LAS u32x4*)(vst + (u ^ 1) * VB_BYTES + pt * 64 * KROW) = vreg[pt];
            }
            __syncthreads();
        }
    }
    const float l_tot = xhalf_sum(l_run);
    const float inv = 1.0f / l_tot;
    bf16_t* orow = Op + (size_t)(wid * 32 + j) * ldo + 4 * hi;
#pragma unroll
    for (int db = 0; db < NDB; ++db)
#pragma unroll
        for (int g = 0; g < 4; ++g) {
            u32x2 w; w.x = cvtpk(o[db][4 * g] * inv, o[db][4 * g + 1] * inv); w.y = cvtpk(o[db][4 * g + 2] * inv, o[db][4 * g + 3] * inv);
            *(u32x2*)(orow + 32 * db + 8 * g) = w;
        }
}
template <int KIND>
__device__ __forceinline__ void phase_attn(LAS unsigned char* lds, int jj) {
    constexpr int DV = (KIND == 0) ? 128 : 64, MODE = (KIND == 1) ? 1 : 0;
    constexpr int ldq = (KIND == 2) ? 1536 : 3072, kv_shift = (KIND == 2) ? 2 : 0, vh_shift = (KIND == 0) ? 1 : (KIND == 2 ? 2 : 0), VW = (KIND == 2) ? 256 : 1024, ldo = (KIND == 0) ? 2048 : 1024;
    const KP kp = kparams(); const Ids I = ids();
    const bf16_t* Q = (const bf16_t*)(kp->ws + WS_R1); const bf16_t* Kt = (const bf16_t*)(kp->ws + WS_R2); const bf16_t* Vt = (const bf16_t*)(kp->ws + WS_R3);
    bf16_t* O = (bf16_t*)(kp->ws + WS_R5);
    constexpr int NKH = (KIND == 2) ? 4 : 16, NVH = VW / DV;
    const float* rpb = (KIND == 1) ? kp->na_rpb + (size_t)jj * 16 * 465 : nullptr;
    constexpr int NU = BATCH * 16 * 32;
    for (int u = I.vcu; u < NU; u += I.G) {
        const int bh = u >> 5, qb = u & 31, b = bh >> 4, hd = bh & 15;
        const bf16_t* Qp = Q + (size_t)(b * SEQ + qb * 256) * ldq + hd * 64;
        const bf16_t* Kp = Kt + (size_t)(b * NKH + (hd >> kv_shift)) * (SEQ / 64) * 4096;
        const bf16_t* Vp = Vt + (size_t)(b * NVH + (hd >> vh_shift)) * (SEQ / 64) * (DV * 64);
        bf16_t* Op = O + (size_t)(b * SEQ + qb * 256) * ldo + hd * DV;
        int t_lo = 0, t_hi = SEQ / 64;
        if (MODE == 1) { const int r4 = 4 * qb; t_lo = r4 - 4; t_lo = t_lo < 0 ? 0 : (t_lo > 120 ? 120 : t_lo); int rl = r4 + 3 - 4; rl = rl < 0 ? 0 : (rl > 120 ? 120 : rl); t_hi = rl + 8; }
        if (MODE == 1) attn_unit<DV, MODE>(lds, Qp, ldq, Kp, ldq, Vp, Op, ldo, t_lo, t_hi, rpb + hd * 465, 4 * qb, I.tid);
        else attn_unit_dense<DV>(lds, Qp, ldq, Kp, ldq, Vp, Op, ldo, I.tid, 4 * qb);
    }
}
template <bool SWIGLU>
__device__ __forceinline__ void phase_gemm(LAS unsigned char* lds, int which, int f, int Nin, int kind) {
    const KP kp = kparams(); int b = blockIdx.x; asm volatile("" : "+s"(b)); const int G = gridDim.x;
    unsigned char* ws = kp->ws;
    if (SWIGLU) {
        pg8::Gemm g{(const bf16_t*)(ws + WS_R2), (const bf16_t*)(ws + WS_W + (f ? WO_GU1 : WO_GU0)), T, 2 * DFF, DM}; pg8::StaticOrder S; S.init(T, 2 * DFF, G, b);
        pg8::EpiSwiglu E{(bf16_t*)(ws + WS_R1), DFF};
        pg8::gemm_phase<pg8::EpiSwiglu, pg8::StaticOrder, true, true>(lds, g, S, E);
    } else {
        const bf16_t* A; const bf16_t* Bt; bf16_t* O; int N, K;
        if (which == 1) { A = (const bf16_t*)(ws + WS_R1); Bt = (const bf16_t*)(ws + WS_W + (f ? WO_D1 : WO_D0)); O = (bf16_t*)(ws + WS_R3); N = DM; K = DFF; }
        else if (which == 2) { A = (const bf16_t*)(ws + WS_R2); Bt = (const bf16_t*)(ws + WS_W + WO_IN); O = (bf16_t*)(ws + WS_R1); N = Nin; K = DM; }
        else { A = (const bf16_t*)(ws + (kind == 0 ? WS_R2 : WS_R5)); Bt = (const bf16_t*)(ws + WS_W + WO_OUT); O = (bf16_t*)(ws + WS_R3); N = DM; K = DM; }
        pg8::Gemm g{A, Bt, T, N, K}; pg8::StaticOrder S; S.init(T, N, G, b);
        pg8::EpiStore E{O, N, (which == 2 && Nin == 3072) ? 1024 : 0, 0.125f * LOG2E};
        pg8::gemm_phase<pg8::EpiStore, pg8::StaticOrder, true, true>(lds, g, S, E);
    }
}

__global__ void __launch_bounds__(512, 2) fwd_kernel(Params p_unused) {
    extern __shared__ __attribute__((aligned(16))) unsigned char lds_raw[];
    LAS unsigned char* lds = (LAS unsigned char*)lds_raw;
    cg::grid_group grid = cg::this_grid();

    phase_convert(0, lds);
    phase_init_rows();
    grid.sync();

    for (int layer = 0; layer < 4; ++layer) {
        const int kind = layer % 3, jj = layer / 3;
        const int Nin = (kind == 2) ? 1536 : 3072;
        for (int sub = 0; sub < 3; ++sub) {
            if (sub != 1) {
                phase_gemm<true>(lds, 0, sub >> 1, 0, 0);
                grid.sync();
            }
            for (int rep = 0; rep < 2; ++rep) {
                if (rep == 1) {
                    if (sub != 1) break;
                    if (kind == 0) {
                        phase_post_a();
                        phase_kpack<0>(jj);
                        phase_vt(3072, 2048, 1024, 128, lds);
                        grid.sync();
                        phase_attn<0>(lds, jj);
                        grid.sync();
                        phase_subln(layer, jj);
                    } else if (kind == 1) {
                        phase_kpack<1>(jj);
                        phase_vt(3072, 2048, 1024, 64, lds);
                        grid.sync();
                        phase_attn<1>(lds, jj);
                    } else {
                        phase_post_c(jj);
                        phase_kpack<2>(jj);
                        phase_vt(1536, 1280, 256, 64, lds);
                        grid.sync();
                        phase_attn<2>(lds, jj);
                    }
                    grid.sync();
                }
                phase_gemm<false>(lds, rep == 1 ? 3 : (sub == 1 ? 2 : 1), sub >> 1, Nin, kind);
                grid.sync();
            }
            phase_rowwise(layer, sub);
            if (sub == 2 && layer < 3) phase_convert(layer + 1, lds);
            grid.sync();
        }
    }
}

extern "C" void kernel_launch(void* const* d_in, const int* in_sizes, int n_in, void* d_out, int out_size, void* d_ws, size_t ws_size, hipStream_t stream) {
    static int grid_blocks = 0;
    if (grid_blocks == 0) {
        if (n_in != 18 || in_sizes[0] != T * DM || out_size != T * DM || ws_size < WS_END) {
            fprintf(stderr, "kernel_launch: unexpected shapes: n_in %d in0 %d out %d ws %zu (need %zu)\n", n_in, n_in > 0 ? in_sizes[0] : -1, out_size, ws_size, (size_t)WS_END);
            grid_blocks = -1; return; }
        int dev = 0, cus = 0, per_cu = 0;
        hipGetDevice(&dev);
        hipDeviceGetAttribute(&cus, hipDeviceAttributeMultiprocessorCount, dev);
        if (hipFuncSetAttribute((const void*)fwd_kernel, hipFuncAttributeMaxDynamicSharedMemorySize, LDS_BYTES) != hipSuccess) { fprintf(stderr, "kernel_launch: hipFuncSetAttribute failed\n"); grid_blocks = -1; return; }
        if (hipOccupancyMaxActiveBlocksPerMultiprocessor(&per_cu, (const void*)fwd_kernel, 512, LDS_BYTES) != hipSuccess || per_cu < 1) { fprintf(stderr, "kernel_launch: occupancy query failed (%d)\n", per_cu); per_cu = 1; }
        (void)hipGetLastError();
        grid_blocks = cus * per_cu;
    }
    if (grid_blocks < 0) return;
    Params p{};
    p.x = (const float*)d_in[0]; p.norm_g = (const float*)d_in[1];
    p.ffn_wg[0] = (const float*)d_in[2]; p.ffn_wu[0] = (const float*)d_in[3]; p.ffn_wd[0] = (const float*)d_in[4];
    p.ffn_wg[1] = (const float*)d_in[5]; p.ffn_wu[1] = (const float*)d_in[6]; p.ffn_wd[1] = (const float*)d_in[7];
    p.diff_w_in = (const float*)d_in[8]; p.diff_w_out = (const float*)d_in[9]; p.diff_lambda = (const float*)d_in[10]; p.diff_subln = (const float*)d_in[11];
    p.na_w_in = (const float*)d_in[12]; p.na_w_out = (const float*)d_in[13]; p.na_rpb = (const float*)d_in[14];
    p.gqa_w_in = (const float*)d_in[15]; p.gqa_w_out = (const float*)d_in[16]; p.gqa_qk_norm = (const float*)d_in[17];
    p.out = (float*)d_out; p.ws = (unsigned char*)d_ws;
    for (int j = 0; j < 8; ++j) p.inv_a[j] = (float)pow(500000.0, -(double)(2 * j) / 16.0);
    for (int j = 0; j < 16; ++j) p.inv_c[j] = (float)pow(10000.0, -(double)(2 * j) / 32.0);
    void* args[] = {&p};
    hipError_t e = hipLaunchCooperativeKernel((const void*)fwd_kernel, dim3(grid_blocks), dim3(512), args, LDS_BYTES, stream);
    if (e != hipSuccess) fprintf(stderr, "kernel_launch: cooperative launch failed: %s (grid %d)\n", hipGetErrorString(e), grid_blocks);
}
```

```cpp
#include <hip/hip_runtime.h>
#include <hip/hip_cooperative_groups.h>
#include <cstdio>
#include <cstdint>
#include <cmath>
namespace cg = cooperative_groups;
namespace pg8 {
#define PG8_LAS __attribute__((address_space(3)))
typedef unsigned short bf16_t;
typedef short bf16x8 __attribute__((ext_vector_type(8)));
typedef float f32x4 __attribute__((ext_vector_type(4)));
typedef unsigned u32x4 __attribute__((ext_vector_type(4)));
constexpr int BM = 256, BK = 64, HALF = 128, HTB = HALF * BK * 2  , STAGE_BYTES = 8 * HTB, NXCD = 8, WGM = 8;

__host__ __device__ __forceinline__ int lds_byte(int r, int c) { const int st = (r >> 4) * 2 + (c >> 5), rr = r & 15, cc = c & 31, ob = rr * 64 + cc * 2; return st * 1024 + (ob ^ (((ob >> 9) & 1) << 5)); }
__host__ __device__ __forceinline__ void stage_rc(int b, int& R, int& C) { const int st = b / 1024, sb = b % 1024, swz = sb ^ (((sb >> 9) & 1) << 5); R = (st >> 1) * 16 + swz / 64; C = (st & 1) * 32 + (swz % 64) / 2; }
__host__ __device__ __forceinline__ int perm32(int rho) { const int n = rho >> 4, i = rho & 15; return 8 * (i >> 2) + 4 * n + (i & 3); }

struct Unit { int pm, pn; };
struct Gemm { const bf16_t* A; const bf16_t* Bt; int M, N, K; };

struct StaticOrder {
    int nM, nN, nwg, G, c;
    __host__ __device__ void init(int M, int N, int G_, int c_) { nM = M / BM; nN = N / BM; nwg = nM * nN; G = G_; c = c_; }
    __host__ __device__ bool next(int i, Unit& u) const {
        const long L = (long)i * G + c; if (L >= nwg) return false;
        int wgid = (int)L; { const int q = nwg / NXCD, r = nwg % NXCD, xcd = wgid % NXCD, off = wgid / NXCD; wgid = (xcd < r ? xcd * (q + 1) : r * (q + 1) + (xcd - r) * q) + off; }
        const int nig = WGM * nN, gid = wgid / nig, fm = gid * WGM, gsz = (nM - fm) < WGM ? (nM - fm) : WGM;
        u.pm = fm + ((wgid % nig) % gsz); u.pn = (wgid % nig) / gsz; return true;
    }
    __device__ __forceinline__ void a_ready(const Unit&) const {}
    __device__ __forceinline__ void done(const Unit&) const {}
};

__device__ __forceinline__ unsigned cvt_pk_bf16(float lo, float hi) { unsigned r; asm volatile("v_cvt_pk_bf16_f32 %0, %1, %2" : "=v"(r) : "v"(lo), "v"(hi)); return r; }
typedef float f32x2 __attribute__((ext_vector_type(2)));
struct EpiStore {
    static constexpr bool PERM = true, AFTER_DRAIN = false;
    bf16_t* O; int ldc; int scale_cols; float scale0;
    __device__ __forceinline__ void operator()(const f32x4 (&acc)[2][2][4][2], const Unit& u, int wr, int wc, int fr, int fq) const {
        const int row0 = u.pm * BM + wr * 64 + fr; const int col0 = u.pn * BM + wc * 32 + 8 * fq;
        const float sc = (u.pn * BM < scale_cols) ? scale0 : 1.0f;
#pragma unroll
        for (int ai = 0; ai < 2; ++ai)
#pragma unroll
            for (int m = 0; m < 4; ++m) { bf16_t* rowp = O + (size_t)(row0 + ai * HALF + m * 16) * ldc + col0;
#pragma unroll
                for (int bj = 0; bj < 2; ++bj) { const f32x4 v0 = acc[ai][bj][m][0] * sc, v1 = acc[ai][bj][m][1] * sc;
                    u32x4 w; w.x = cvt_pk_bf16(v0[0], v0[1]); w.y = cvt_pk_bf16(v0[2], v0[3]); w.z = cvt_pk_bf16(v1[0], v1[1]); w.w = cvt_pk_bf16(v1[2], v1[3]);
                    *(u32x4*)(rowp + bj * HALF) = w; } }
    }
};
__device__ __forceinline__ float silu_mul(float g, float u) { const float e = __builtin_amdgcn_exp2f(g * -1.4426950408889634f); return g * __builtin_amdgcn_rcpf(1.0f + e) * u; }
struct EpiSwiglu {
    static constexpr bool PERM = true, AFTER_DRAIN = false;
    bf16_t* O; int ldc;
    __device__ __forceinline__ void operator()(const f32x4 (&acc)[2][2][4][2], const Unit& u, int wr, int wc, int fr, int fq) const {
        const int row0 = u.pm * BM + wr * 64 + fr; const int col0 = u.pn * HALF + wc * 32 + 8 * fq;
#pragma unroll
        for (int ai = 0; ai < 2; ++ai)
#pragma unroll
            for (int m = 0; m < 4; ++m) { bf16_t* rowp = O + (size_t)(row0 + ai * HALF + m * 16) * ldc + col0;
                const f32x4 g0 = acc[ai][0][m][0], g1 = acc[ai][0][m][1], u0 = acc[ai][1][m][0], u1 = acc[ai][1][m][1];
                u32x4 w; w.x = cvt_pk_bf16(silu_mul(g0[0], u0[0]), silu_mul(g0[1], u0[1])); w.y = cvt_pk_bf16(silu_mul(g0[2], u0[2]), silu_mul(g0[3], u0[3]));
                w.z = cvt_pk_bf16(silu_mul(g1[0], u1[0]), silu_mul(g1[1], u1[1])); w.w = cvt_pk_bf16(silu_mul(g1[2], u1[2]), silu_mul(g1[3], u1[3]));
                *(u32x4*)rowp = w; }
    }
};
template <class Epi, class Sched, bool ALIGN_EPI = false, bool SP2 = false>
__device__ __forceinline__ void gemm_phase(PG8_LAS unsigned char* lds, const Gemm g, const Sched& S, const Epi& E) {
    int tid_l = threadIdx.x; asm volatile("" : "+v"(tid_l));
    const int tid = tid_l, wid = __builtin_amdgcn_readfirstlane(tid >> 6), lane = tid & 63, wr = wid >> 2, wc = wid & 3, fr = lane & 15, fq = lane >> 4;
    const int K = g.K, nt = K / BK;
    unsigned voffA[2], voffB[2];
#pragma unroll
    for (int i = 0; i < 2; ++i) { int R, C; stage_rc(tid * 16 + i * 8192, R, C); const int Rb = Epi::PERM ? ((R & ~31) + perm32(R & 31)) : R;
        voffA[i] = (unsigned)(R * K + C) * 2u; voffB[i] = (unsigned)(Rb * K + C) * 2u; }
    const size_t kstep = (size_t)(BK * 2);
    const size_t hstep = (size_t)HALF * K * 2;
    const size_t tstep = 2 * hstep;
    const unsigned ldsw = (unsigned)wid * 1024u;
    const int aoff = lds_byte(wr * 64 + fr, fq * 8), boff = lds_byte(wc * 32 + fr, fq * 8);
#define PG8_SA(b, h) (((b) * 2 + (h)) * HTB)
#define PG8_SB(b, h) ((4 + (b) * 2 + (h)) * HTB)
#define PG8_STAGE(bufoff, gbase, voff) do { _Pragma("unroll") for (int _i = 0; _i < 2; ++_i) \
        __builtin_amdgcn_global_load_lds((const unsigned*)((const char*)(gbase) + (voff)[_i]), (PG8_LAS unsigned*)(lds + (bufoff) + ldsw + _i * 8192), 16, 0, 0); } while (0)
#define PG8_LDA(dst, b, h) do { _Pragma("unroll") for (int m = 0; m < 4; ++m) _Pragma("unroll") for (int k = 0; k < 2; ++k) dst[m][k] = *(const PG8_LAS bf16x8*)(lds + PG8_SA(b, h) + aoff + m * 2048 + k * 1024); } while (0)
#define PG8_LDB(dst, b, h) do { _Pragma("unroll") for (int n = 0; n < 2; ++n) _Pragma("unroll") for (int k = 0; k < 2; ++k) dst[n][k] = *(const PG8_LAS bf16x8*)(lds + PG8_SB(b, h) + boff + n * 2048 + k * 1024); } while (0)
#define PG8_MMA(ai, bj, At, Bt) do { __builtin_amdgcn_s_setprio(1); _Pragma("unroll") for (int m = 0; m < 4; ++m) _Pragma("unroll") for (int n = 0; n < 2; ++n) _Pragma("unroll") for (int k = 0; k < 2; ++k) \
        acc[ai][bj][m][n] = __builtin_amdgcn_mfma_f32_16x16x32_bf16(Bt[n][k], At[m][k], acc[ai][bj][m][n], 0, 0, 0); __builtin_amdgcn_s_setprio(0); } while (0)
#define PG8_WAIT_V(n) asm volatile("s_waitcnt vmcnt(" #n ")" ::: "memory")
#define PG8_WAIT_L(n) asm volatile("s_waitcnt lgkmcnt(" #n ")" ::: "memory")
#define PG8_BAR __builtin_amdgcn_s_barrier()
#define PG8_SCHED __builtin_amdgcn_sched_barrier(0)
    Unit cur, nxt; int ui = 0;
    if (!S.next(0, cur)) return;
    f32x4 acc[2][2][4][2];
#pragma unroll
    for (int a = 0; a < 2; ++a)
#pragma unroll
        for (int b = 0; b < 2; ++b)
#pragma unroll
            for (int m = 0; m < 4; ++m)
#pragma unroll
                for (int n = 0; n < 2; ++n) acc[a][b][m][n] = (f32x4){0.f, 0.f, 0.f, 0.f};
    bf16x8 At[4][2], B0[2][2], B1[2][2];
    const char* cA = (const char*)g.A + (size_t)cur.pm * tstep; const char* cB = (const char*)g.Bt + (size_t)cur.pn * tstep;
    S.a_ready(cur);
    if constexpr (SP2) {
        PG8_STAGE(PG8_SB(0, 0), cB, voffB); PG8_STAGE(PG8_SB(0, 1), cB + hstep, voffB); PG8_STAGE(PG8_SA(0, 0), cA, voffA); PG8_STAGE(PG8_SA(0, 1), cA + hstep, voffA);
        if (wr == 1) PG8_BAR;
        PG8_WAIT_V(2); PG8_BAR;
        PG8_STAGE(PG8_SB(1, 0), cB + kstep, voffB); PG8_STAGE(PG8_SA(1, 0), cA + kstep, voffA); PG8_STAGE(PG8_SB(1, 1), cB + hstep + kstep, voffB);
        PG8_WAIT_V(6); PG8_BAR;
    } else {
        PG8_STAGE(PG8_SB(0, 0), cB, voffB); PG8_STAGE(PG8_SA(0, 0), cA, voffA); PG8_STAGE(PG8_SB(0, 1), cB + hstep, voffB); PG8_STAGE(PG8_SA(0, 1), cA + hstep, voffA);
        if (wr == 1) PG8_BAR;
        PG8_WAIT_V(4); PG8_BAR;
        PG8_STAGE(PG8_SB(1, 0), cB + kstep, voffB); PG8_STAGE(PG8_SA(1, 0), cA + kstep, voffA); PG8_STAGE(PG8_SB(1, 1), cB + hstep + kstep, voffB);
        PG8_WAIT_V(6); PG8_BAR;
    }
    for (;;) {
        const bool has_next = S.next(ui + 1, nxt);
        const char* nA = has_next ? (const char*)g.A + (size_t)nxt.pm * tstep : cA; const char* nB = has_next ? (const char*)g.Bt + (size_t)nxt.pn * tstep : cB;
        for (int t = 0; t < nt; t += 2) {
            const bool last = (t == nt - 2);
            const char* a1 = cA + (size_t)(t + 1) * kstep;
            const char* a2 = last ? nA : cA + (size_t)(t + 2) * kstep; const char* b2 = last ? nB : cB + (size_t)(t + 2) * kstep;
            const char* a3 = a2 + kstep; const char* b3 = b2 + kstep;
            if (last && has_next) S.a_ready(nxt);
            if constexpr (SP2) {
            PG8_LDB(B0, 0, 0); PG8_LDB(B1, 0, 1); PG8_SCHED; PG8_LDA(At, 0, 0); PG8_STAGE(PG8_SA(1, 1), a1 + hstep, voffA);
            PG8_WAIT_V(8); PG8_WAIT_L(0); PG8_BAR; PG8_MMA(0, 0, At, B0); PG8_MMA(0, 1, At, B1); PG8_BAR; PG8_SCHED;
            PG8_LDA(At, 0, 1); PG8_STAGE(PG8_SB(0, 0), b2, voffB); PG8_STAGE(PG8_SB(0, 1), b2 + hstep, voffB); PG8_STAGE(PG8_SA(0, 0), a2, voffA);
            PG8_WAIT_V(8); PG8_WAIT_L(0); PG8_BAR; PG8_MMA(1, 0, At, B0); PG8_MMA(1, 1, At, B1); PG8_BAR; PG8_SCHED;
            PG8_LDB(B0, 1, 0); PG8_LDB(B1, 1, 1); PG8_SCHED; PG8_LDA(At, 1, 0); PG8_STAGE(PG8_SA(0, 1), a2 + hstep, voffA);
            PG8_WAIT_V(8); PG8_WAIT_L(0); PG8_BAR; PG8_MMA(0, 0, At, B0); PG8_MMA(0, 1, At, B1); PG8_BAR; PG8_SCHED;
            PG8_LDA(At, 1, 1); PG8_STAGE(PG8_SB(1, 0), b3, voffB); PG8_STAGE(PG8_SB(1, 1), b3 + hstep, voffB); PG8_STAGE(PG8_SA(1, 0), a3, voffA);
            PG8_WAIT_V(8); PG8_WAIT_L(0); PG8_BAR; PG8_MMA(1, 0, At, B0); PG8_MMA(1, 1, At, B1); PG8_BAR; PG8_SCHED;
            } else {
            PG8_LDB(B0, 0, 0); PG8_SCHED; PG8_LDA(At, 0, 0); PG8_STAGE(PG8_SA(1, 1), a1 + hstep, voffA);
            PG8_WAIT_L(8); PG8_BAR; PG8_WAIT_L(0); PG8_MMA(0, 0, At, B0); PG8_BAR; PG8_SCHED;
            PG8_LDB(B1, 0, 1); PG8_STAGE(PG8_SB(0, 0), b2, voffB);
            PG8_BAR; PG8_WAIT_L(0); PG8_MMA(0, 1, At, B1); PG8_BAR;
            PG8_LDA(At, 0, 1); PG8_STAGE(PG8_SA(0, 0), a2, voffA);
            PG8_BAR; PG8_WAIT_L(0); PG8_MMA(1, 0, At, B0); PG8_BAR; PG8_SCHED;
            PG8_STAGE(PG8_SB(0, 1), b2 + hstep, voffB);
            PG8_WAIT_V(6); PG8_BAR; PG8_MMA(1, 1, At, B1); PG8_BAR;
            PG8_LDB(B0, 1, 0); PG8_SCHED; PG8_LDA(At, 1, 0); PG8_STAGE(PG8_SA(0, 1), a2 + hstep, voffA);
            PG8_WAIT_L(8); PG8_BAR; PG8_WAIT_L(0); PG8_MMA(0, 0, At, B0); PG8_BAR; PG8_SCHED;
            PG8_LDB(B1, 1, 1); PG8_STAGE(PG8_SB(1, 0), b3, voffB);
            PG8_BAR; PG8_WAIT_L(0); PG8_MMA(0, 1, At, B1); PG8_BAR;
            PG8_LDA(At, 1, 1); PG8_STAGE(PG8_SA(1, 0), a3, voffA);
            PG8_BAR; PG8_WAIT_L(0); PG8_MMA(1, 0, At, B0); PG8_BAR; PG8_SCHED;
            PG8_STAGE(PG8_SB(1, 1), b3 + hstep, voffB);
            PG8_WAIT_V(6); PG8_BAR; PG8_MMA(1, 1, At, B1); PG8_BAR;
            }
        }
        if constexpr (ALIGN_EPI) { if (wr == 0) PG8_BAR; }
        if constexpr (!Epi::AFTER_DRAIN) { E(acc, cur, wr, wc, fr, fq); S.done(cur); }
        if (!has_next) break;
#pragma unroll
        for (int a = 0; a < 2; ++a)
#pragma unroll
            for (int b = 0; b < 2; ++b)
#pragma unroll
                for (int m = 0; m < 4; ++m)
#pragma unroll
                    for (int n = 0; n < 2; ++n) acc[a][b][m][n] = (f32x4){0.f, 0.f, 0.f, 0.f};
        cur = nxt; cA = nA; cB = nB; ++ui;
        if constexpr (ALIGN_EPI) { if (wr == 1) PG8_BAR; }
    }
    PG8_WAIT_V(0);
    if constexpr (!ALIGN_EPI) { if (wr == 0) PG8_BAR; }
    PG8_BAR;
    if constexpr (Epi::AFTER_DRAIN) { E.fused(acc, cur, wr, wc, fr, fq, lds, wid, lane); S.done(cur); }
#undef PG8_SA
#undef PG8_SB
#undef PG8_STAGE
#undef PG8_LDA
#undef PG8_LDB
#undef PG8_MMA
#undef PG8_WAIT_V
#undef PG8_WAIT_L
#undef PG8_BAR
#undef PG8_SCHED
}
}

#define LAS __attribute__((address_space(3)))
typedef unsigned short bf16_t;
typedef short bf16x8 __attribute__((ext_vector_type(8)));
typedef float f32x4 __attribute__((ext_vector_type(4)));
typedef float f32x16 __attribute__((ext_vector_type(16)));
typedef unsigned u32x4 __attribute__((ext_vector_type(4)));
typedef unsigned u32x2 __attribute__((ext_vector_type(2)));

constexpr int BATCH = 4, SEQ = 8192, DM = 1024, DFF = 2816, T = BATCH * SEQ;
constexpr float EPS = 1e-6f;
constexpr float LOG2E = 1.4426950408889634f;
constexpr size_t MiB = 1u << 20;
constexpr size_t WS_R1 = 0;
constexpr size_t WS_R2 = 192 * MiB;
constexpr size_t WS_R3 = 256 * MiB;
constexpr size_t WS_R5 = 320 * MiB;
constexpr size_t WS_W = 448 * MiB;
constexpr size_t WO_GU0 = 0, WO_D0 = 11 * MiB, WO_GU1 = 17 * MiB, WO_D1 = 28 * MiB, WO_IN = 34 * MiB, WO_OUT = 40 * MiB;
constexpr size_t WS_END = 492 * MiB;
constexpr size_t WS_BAR = 500 * MiB;
constexpr size_t WS_NEED = 501 * MiB;
constexpr int LDS_ST_OFF = 131072 + 64;
constexpr int LDS_BYTES = 135168;

struct Params {
    const float* x; const float* norm_g;
    const float* ffn_wg[2]; const float* ffn_wu[2]; const float* ffn_wd[2];
    const float* diff_w_in; const float* diff_w_out; const float* diff_lambda; const float* diff_subln;
    const float* na_w_in; const float* na_w_out; const float* na_rpb;
    const float* gqa_w_in; const float* gqa_w_out; const float* gqa_qk_norm;
    float* out; unsigned char* ws;
    float inv_a[8]; float inv_c[16];
};

typedef const __attribute__((address_space(4))) Params* KP;
__device__ __forceinline__ KP kparams() { KP k = (KP)__builtin_amdgcn_kernarg_segment_ptr(); asm volatile("" : "+s"(k)); return k; }
struct Ids { int tid, lane, wave, vcu, G, bx, gw, NGW, gtid, NTH; };
__device__ __forceinline__ Ids ids() {
    Ids I; int t = threadIdx.x; asm volatile("" : "+v"(t)); int b = blockIdx.x; asm volatile("" : "+s"(b));
    I.tid = t; I.lane = t & 63; I.wave = __builtin_amdgcn_readfirstlane(t >> 6); I.G = gridDim.x; I.bx = b;
    I.vcu = (I.G % 8 == 0) ? (b % 8) * (I.G / 8) + b / 8 : b;
    I.gw = I.vcu * 8 + I.wave; I.NGW = I.G * 8; I.gtid = I.vcu * 512 + t; I.NTH = I.G * 512; return I;
}
__device__ __forceinline__ unsigned f2bf(float f) { unsigned u = __builtin_bit_cast(unsigned, f); return (u + 0x7fffu + ((u >> 16) & 1u)) >> 16; }
__device__ __forceinline__ unsigned pk2(float lo, float hi) { return f2bf(lo) | (f2bf(hi) << 16); }
__device__ __forceinline__ float bflo(unsigned w) { return __builtin_bit_cast(float, w << 16); }
__device__ __forceinline__ float bfhi(unsigned w) { return __builtin_bit_cast(float, w & 0xffff0000u); }
__device__ __forceinline__ float wave_sum(float v) {
#pragma unroll
    for (int o = 1; o < 64; o <<= 1) v += __shfl_xor(v, o);
    return v;
}
__device__ __forceinline__ void sincos_rr(float ang, float& s, float& c) {
    double rev = (double)ang * 0.15915494309189535; rev -= __builtin_floor(rev);
    const float fr = (float)rev;
    s = __builtin_amdgcn_sinf(fr); c = __builtin_amdgcn_cosf(fr);
}

#define XB_TMO      128
#define XB_XCNT(j)  (256  + 64 * (j))
#define XB_XSUB(j)  (1280 + 64 * (j))
#define XB_XGEN(j)  (2304 + 64 * (j))
#define XB_TOP      3328
#define XB_TOPGEN   3392
#define XCD_BAR_WORDS 3456
#define XB_SPIN_CAP (1u << 18)

__device__ __forceinline__ unsigned xb_ld(unsigned* p)              { return __hip_atomic_load(p, __ATOMIC_RELAXED, __HIP_MEMORY_SCOPE_AGENT); }
__device__ __forceinline__ unsigned xb_add(unsigned* p, unsigned v) { return __hip_atomic_fetch_add(p, v, __ATOMIC_RELAXED, __HIP_MEMORY_SCOPE_AGENT); }
__device__ __forceinline__ unsigned xb_xcc_id() { return (unsigned)__builtin_amdgcn_s_getreg((3 << 11) | 20) & 0xFu; }
#define XB_SPIN(cond, bar) do { unsigned _sp = 0; while (cond) { __builtin_amdgcn_s_sleep(1); \
    if ((++_sp & 255u) == 0u) { if (xb_ld(&(bar)[XB_TMO])) break; if (_sp > XB_SPIN_CAP) { atomicAdd(&(bar)[XB_TMO], 1u); break; } } } } while (0)

struct XcdBarrier {
    unsigned* bar; unsigned x;
    volatile LAS unsigned* st;
};

__device__ __forceinline__ XcdBarrier xcd_barrier_post(unsigned* bar, volatile LAS unsigned* st) {
    XcdBarrier b; b.bar = bar; b.x = xb_xcc_id(); b.st = st;
    if (threadIdx.x == 0) (void)xb_add(&bar[XB_XCNT(b.x)], 1u);
    return b;
}
__device__ __forceinline__ void xcd_barrier_complete(unsigned* bar, unsigned x, unsigned& nloc, unsigned& nx) {
    const unsigned G = gridDim.x * gridDim.y * gridDim.z;
    unsigned sum, cnt, mine, sp = 0u;
    for (;;) {
        sum = 0u; cnt = 0u; mine = 0u;
#pragma unroll
        for (unsigned j = 0; j < 16; ++j) { const unsigned c = xb_ld(&bar[XB_XCNT(j)]); sum += c; cnt += (c > 0u) ? 1u : 0u; mine = (j == x) ? c : mine; }
        if (sum == G) break;
        __builtin_amdgcn_s_sleep(1);
        if ((++sp & 255u) == 0u) { if (xb_ld(&bar[XB_TMO])) break; if (sp > XB_SPIN_CAP) { atomicAdd(&bar[XB_TMO], 1u); break; } }
    }
    nloc = mine > 0u ? mine : 1u; nx = cnt > 0u ? cnt : 1u;
}

__device__ __forceinline__ void xcd_barrier(const XcdBarrier& b) {
    asm volatile("s_waitcnt vmcnt(0)" ::: "memory");
    __syncthreads();
    if (threadIdx.x == 0) {
        unsigned* bar = b.bar;
        __builtin_amdgcn_s_waitcnt(0);
        unsigned nloc = b.st[0], nx = b.st[1];
        if (nloc == 0u) { xcd_barrier_complete(bar, b.x, nloc, nx); b.st[0] = nloc; b.st[1] = nx; }
        const unsigned old = xb_add(&bar[XB_XSUB(b.x)], 1u);
        const unsigned gen = old / nloc;
        if (old + 1u == (gen + 1u) * nloc) {
            __builtin_amdgcn_fence(__ATOMIC_RELEASE, "agent");
            asm volatile("s_waitcnt vmcnt(0)" ::: "memory");
            const unsigned og = xb_add(&bar[XB_TOP], 1u);
            const unsigned tg = og / nx;
            if (og + 1u == (tg + 1u) * nx) xb_add(&bar[XB_TOPGEN], 1u);
            else XB_SPIN(xb_ld(&bar[XB_TOPGEN]) == tg, bar);
            __builtin_amdgcn_fence(__ATOMIC_ACQUIRE, "agent");
            xb_add(&bar[XB_XGEN(b.x)], 1u);
            asm volatile("s_waitcnt vmcnt(0)" ::: "memory");
        } else {
            XB_SPIN(xb_ld(&bar[XB_XGEN(b.x)]) == gen, bar);
            __builtin_amdgcn_fence(__ATOMIC_ACQUIRE, "agent");
            asm volatile("s_waitcnt vmcnt(0)" ::: "memory");
        }
    }
    __syncthreads();
}

__device__ __forceinline__ void transpose_item(const float* __restrict__ W, int K, int N, bf16_t* __restrict__ WT, int k0, int n0, int orow0, LAS float* scr, int lane) {
#pragma unroll 8
    for (int i = 0; i < 32; ++i) { const int kk = 2 * i + (lane >> 5); scr[kk * 33 + (lane & 31)] = W[(size_t)(k0 + kk) * N + n0 + (lane & 31)]; }
    asm volatile("s_waitcnt lgkmcnt(0)" ::: "memory");
    const int c = lane & 7;
#pragma unroll
    for (int j = 0; j < 4; ++j) { const int n = (lane >> 3) + 8 * j; const LAS float* s = scr + (8 * c) * 33 + n;
        u32x4 o; o.x = pk2(s[0 * 33], s[1 * 33]); o.y = pk2(s[2 * 33], s[3 * 33]); o.z = pk2(s[4 * 33], s[5 * 33]); o.w = pk2(s[6 * 33], s[7 * 33]);
        *(u32x4*)(WT + (size_t)(orow0 + n) * K + k0 + 8 * c) = o; }
    asm volatile("s_waitcnt lgkmcnt(0)" ::: "memory");
}
__device__ __forceinline__ void phase_convert(int layer, LAS unsigned char* lds) {
    layer = __builtin_amdgcn_readfirstlane(layer); asm volatile("" : "+s"(layer));
    const KP kp = kparams(); const Ids I = ids(); const int gw = I.gw, NGW = I.NGW, wave = I.wave, lane = I.lane;
    LAS float* scr = (LAS float*)(lds + wave * 16384);
    unsigned char* wsw = kp->ws + WS_W;
    const int kind = layer % 3, jj = layer / 3;
    const float* w_in; const float* w_out; int Nin;
    if (kind == 0) { w_in = kp->diff_w_in + (size_t)jj * DM * 3072; w_out = kp->diff_w_out + (size_t)jj * DM * DM; Nin = 3072; }
    else if (kind == 1) { w_in = kp->na_w_in + (size_t)jj * DM * 3072; w_out = kp->na_w_out + (size_t)jj * DM * DM; Nin = 3072; }
    else { w_in = kp->gqa_w_in + (size_t)jj * DM * 1536; w_out = kp->gqa_w_out + (size_t)jj * DM * DM; Nin = 1536; }
    constexpr int I_GU = (DM / 64) * (DFF / 32), I_D = (DFF / 64) * (DM / 32), I_OUT = (DM / 64) * (DM / 32);
    const int I_IN = (DM / 64) * (Nin / 32);
    const int total = 2 * (2 * I_GU + I_D) + I_IN + I_OUT;
    const size_t lofs = (size_t)layer * DM * DFF;
    for (int it = gw; it < total; it += NGW) {
        int r = it;
        if (r < 2 * (2 * I_GU + I_D)) {
            const int f = r / (2 * I_GU + I_D); r -= f * (2 * I_GU + I_D);
            bf16_t* gu = (bf16_t*)(wsw + (f ? WO_GU1 : WO_GU0)); bf16_t* wd = (bf16_t*)(wsw + (f ? WO_D1 : WO_D0));
            if (r < 2 * I_GU) {
                const int up = r / I_GU; r -= up * I_GU;
                const float* W = (up ? kp->ffn_wu[f] : kp->ffn_wg[f]) + lofs;
                const int nblk = DFF / 32, kb = r / nblk, nb = r % nblk, n0 = 32 * nb;
                transpose_item(W, DM, DFF, gu, 64 * kb, n0, 256 * (n0 / 128) + (n0 % 128) + 128 * up, scr, lane);
            } else {
                r -= 2 * I_GU;
                const int nblk = DM / 32, kb = r / nblk, nb = r % nblk, n0 = 32 * nb;
                transpose_item(kp->ffn_wd[f] + lofs, DFF, DM, wd, 64 * kb, n0, n0, scr, lane);
            }
        } else {
            r -= 2 * (2 * I_GU + I_D);
            if (r < I_IN) { const int nblk = Nin / 32, kb = r / nblk, nb = r % nblk, n0 = 32 * nb;
                transpose_item(w_in, DM, Nin, (bf16_t*)(wsw + WO_IN), 64 * kb, n0, n0, scr, lane); }
            else { r -= I_IN; const int nblk = DM / 32, kb = r / nblk, nb = r % nblk, n0 = 32 * nb;
                transpose_item(w_out, DM, DM, (bf16_t*)(wsw + WO_OUT), 64 * kb, n0, n0, scr, lane); }
        }
    }
}

__device__ __forceinline__ void phase_init_rows() {
    const KP kp = kparams(); const Ids I = ids(); const int gw = I.gw, NGW = I.NGW, lane = I.lane;
    const float* __restrict__ x = kp->x; float* __restrict__ h = kp->out; bf16_t* __restrict__ xn = (bf16_t*)(kp->ws + WS_R2); const float* __restrict__ g_pre = kp->norm_g;
    for (int row = gw; row < T; row += NGW) {
        const f32x4* xr = (const f32x4*)(x + (size_t)row * DM) + lane;
        f32x4 v[4]; float ss = 0.f;
#pragma unroll
        for (int j = 0; j < 4; ++j) { v[j] = xr[64 * j]; ss += (v[j].x * v[j].x + v[j].y * v[j].y) + (v[j].z * v[j].z + v[j].w * v[j].w); }
        const float rstd = 1.0f / sqrtf(wave_sum(ss) * (1.0f / DM) + EPS);
        f32x4* hr = (f32x4*)(h + (size_t)row * DM) + lane;
        u32x2* o8 = (u32x2*)(xn + (size_t)row * DM) + lane;
#pragma unroll
        for (int j = 0; j < 4; ++j) { hr[64 * j] = v[j]; const f32x4 g = ((const f32x4*)g_pre)[lane + 64 * j];
            u32x2 w; w.x = pk2(v[j].x * rstd * g.x, v[j].y * rstd * g.y); w.y = pk2(v[j].z * rstd * g.z, v[j].w * rstd * g.w); o8[64 * j] = w; }
    }
}
__device__ __forceinline__ void phase_rowwise(int layer, int sub) {
    layer = __builtin_amdgcn_readfirstlane(layer); sub = __builtin_amdgcn_readfirstlane(sub); asm volatile("" : "+s"(layer), "+s"(sub));
    const KP kp = kparams(); const Ids I = ids(); const int gw = I.gw, NGW = I.NGW, lane = I.lane;
    float* __restrict__ h = kp->out; const bf16_t* __restrict__ y = (const bf16_t*)(kp->ws + WS_R3); bf16_t* __restrict__ xn = (bf16_t*)(kp->ws + WS_R2);
    const float* gl = kp->norm_g + (size_t)layer * 6 * DM;
    const float coef = (sub == 1) ? 1.0f : 0.5f;
    const float* __restrict__ g_post = gl + (size_t)(2 * sub + 1) * DM;
    const float* __restrict__ g_pre = (sub < 2) ? gl + (size_t)(2 * sub + 2) * DM : (layer < 3 ? gl + (size_t)6 * DM : nullptr);
    for (int row = gw; row < T; row += NGW) {
        f32x4* hr = (f32x4*)(h + (size_t)row * DM) + lane;
        const u32x2* yr = (const u32x2*)(y + (size_t)row * DM) + lane;
        f32x4 hv[4], yv[4]; float ss = 0.f;
#pragma unroll
        for (int j = 0; j < 4; ++j) { hv[j] = hr[64 * j]; const u32x2 w = yr[64 * j]; yv[j] = (f32x4){bflo(w.x), bfhi(w.x), bflo(w.y), bfhi(w.y)};
            ss += (yv[j].x * yv[j].x + yv[j].y * yv[j].y) + (yv[j].z * yv[j].z + yv[j].w * yv[j].w); }
        const float rs = coef / sqrtf(wave_sum(ss) * (1.0f / DM) + EPS);
        float s2 = 0.f;
#pragma unroll
        for (int j = 0; j < 4; ++j) { const f32x4 g = ((const f32x4*)g_post)[lane + 64 * j];
            hv[j].x += yv[j].x * rs * g.x; hv[j].y += yv[j].y * rs * g.y; hv[j].z += yv[j].z * rs * g.z; hv[j].w += yv[j].w * rs * g.w;
            hr[64 * j] = hv[j];
            s2 += (hv[j].x * hv[j].x + hv[j].y * hv[j].y) + (hv[j].z * hv[j].z + hv[j].w * hv[j].w); }
        if (g_pre) {
            const float rstd = 1.0f / sqrtf(wave_sum(s2) * (1.0f / DM) + EPS);
            u32x2* o8 = (u32x2*)(xn + (size_t)row * DM) + lane;
#pragma unroll
            for (int j = 0; j < 4; ++j) { const f32x4 g = ((const f32x4*)g_pre)[lane + 64 * j];
                u32x2 w; w.x = pk2(hv[j].x * rstd * g.x, hv[j].y * rstd * g.y); w.y = pk2(hv[j].z * rstd * g.z, hv[j].w * rstd * g.w); o8[64 * j] = w; }
        }
    }
}

__device__ __forceinline__ void phase_post_a() {
    const KP kp = kparams(); const Ids I = ids(); const int gtid = I.gtid, NTH = I.NTH;
    bf16_t* raw = (bf16_t*)(kp->ws + WS_R1);
    float inv[8];
#pragma unroll
    for (int j = 0; j < 8; ++j) inv[j] = kp->inv_a[j];
    for (int item = gtid; item < T * 16; item += NTH) {
        const int t = item >> 4, w = item & 15;
        bf16_t* ptr = raw + (size_t)t * 3072 + w * 64;
        const u32x4 a = *(const u32x4*)ptr, b = *(const u32x4*)(ptr + 8);
        float x1[8] = {bflo(a.x), bfhi(a.x), bflo(a.y), bfhi(a.y), bflo(a.z), bfhi(a.z), bflo(a.w), bfhi(a.w)};
        float x2[8] = {bflo(b.x), bfhi(b.x), bflo(b.y), bfhi(b.y), bflo(b.z), bfhi(b.z), bflo(b.w), bfhi(b.w)};
        const float pos = (float)(t & (SEQ - 1));
        float y1[8], y2[8];
#pragma unroll
        for (int j = 0; j < 8; ++j) { float s, c; sincos_rr(pos * inv[j], s, c); y1[j] = x1[j] * c - x2[j] * s; y2[j] = x2[j] * c + x1[j] * s; }
        u32x4 oa, ob;
        oa.x = pk2(y1[0], y1[1]); oa.y = pk2(y1[2], y1[3]); oa.z = pk2(y1[4], y1[5]); oa.w = pk2(y1[6], y1[7]);
        ob.x = pk2(y2[0], y2[1]); ob.y = pk2(y2[2], y2[3]); ob.z = pk2(y2[4], y2[5]); ob.w = pk2(y2[6], y2[7]);
        *(u32x4*)ptr = oa; *(u32x4*)(ptr + 8) = ob;
    }
}
__device__ __forceinline__ void phase_post_c(int jj) {
    const KP kp = kparams(); const Ids I = ids(); const int gtid = I.gtid, NTH = I.NTH;
    bf16_t* raw = (bf16_t*)(kp->ws + WS_R1); const float* __restrict__ qk_g = kp->gqa_qk_norm + (size_t)jj * 128;
    float inv[16];
#pragma unroll
    for (int j = 0; j < 16; ++j) inv[j] = kp->inv_c[j];
    for (int item = gtid; item < T * 16; item += NTH) {
        const int t = item >> 4, hd = item & 15;
        bf16_t* ptr = raw + (size_t)t * 1536 + hd * 64;
        const float* g = qk_g;
        float x[64]; float ss = 0.f;
#pragma unroll
        for (int i = 0; i < 8; ++i) { const u32x4 a = *(const u32x4*)(ptr + 8 * i);
            x[8 * i + 0] = bflo(a.x); x[8 * i + 1] = bfhi(a.x); x[8 * i + 2] = bflo(a.y); x[8 * i + 3] = bfhi(a.y);
            x[8 * i + 4] = bflo(a.z); x[8 * i + 5] = bfhi(a.z); x[8 * i + 6] = bflo(a.w); x[8 * i + 7] = bfhi(a.w); }
#pragma unroll
        for (int i = 0; i < 64; ++i) ss += x[i] * x[i];
        const float rstd = 1.0f / sqrtf(ss * (1.0f / 64.0f) + EPS);
        const float rq = rstd * (0.125f * LOG2E);
#pragma unroll
        for (int i = 0; i < 64; ++i) x[i] = x[i] * rq * g[i];
        const int s_idx = t & (SEQ - 1);
        const float pr = (float)(s_idx >> 6), pc = (float)(s_idx & 63);
#pragma unroll
        for (int j = 0; j < 16; ++j) {
            float s, c; sincos_rr(pr * inv[j], s, c);
            const float a1 = x[j], a2 = x[j + 16]; x[j] = a1 * c - a2 * s; x[j + 16] = a2 * c + a1 * s;
            sincos_rr(pc * inv[j], s, c);
            const float b1 = x[32 + j], b2 = x[48 + j]; x[32 + j] = b1 * c - b2 * s; x[48 + j] = b2 * c + b1 * s;
        }
#pragma unroll
        for (int i = 0; i < 8; ++i) { u32x4 o; o.x = pk2(x[8 * i], x[8 * i + 1]); o.y = pk2(x[8 * i + 2], x[8 * i + 3]); o.z = pk2(x[8 * i + 4], x[8 * i + 5]); o.w = pk2(x[8 * i + 6], x[8 * i + 7]);
            *(u32x4*)(ptr + 8 * i) = o; }
    }
}
template <int KIND>
__device__ __forceinline__ void phase_kpack(int jj) {
    jj = __builtin_amdgcn_readfirstlane(jj); asm volatile("" : "+s"(jj));
    const KP kp = kparams(); const Ids I = ids(); const int gw = I.gw, NGW = I.NGW, lane = I.lane;
    constexpr int LD = (KIND == 2) ? 1536 : 3072, NKH = (KIND == 2) ? 4 : 16;
    const bf16_t* __restrict__ raw = (const bf16_t*)(kp->ws + WS_R1); bf16_t* __restrict__ Kt = (bf16_t*)(kp->ws + WS_R2);
    float inv[16];
#pragma unroll
    for (int j = 0; j < 16; ++j) inv[j] = (KIND == 0) ? kp->inv_a[j & 7] : kp->inv_c[j];
    const float* __restrict__ g = kp->gqa_qk_norm + (size_t)jj * 128 + 64;
    for (int it = gw; it < (T / 64) * NKH; it += NGW) {
        const int tt = it / NKH, hd = it - tt * NKH;
        const int t = tt * 64 + lane, b = t / SEQ, s_idx = t - b * SEQ;
        const bf16_t* src = raw + (size_t)t * LD + 1024 + hd * 64;
        float x[64];
#pragma unroll
        for (int i = 0; i < 8; ++i) { const u32x4 a = *(const u32x4*)(src + 8 * i);
            x[8 * i + 0] = bflo(a.x); x[8 * i + 1] = bfhi(a.x); x[8 * i + 2] = bflo(a.y); x[8 * i + 3] = bfhi(a.y);
            x[8 * i + 4] = bflo(a.z); x[8 * i + 5] = bfhi(a.z); x[8 * i + 6] = bflo(a.w); x[8 * i + 7] = bfhi(a.w); }
        if (KIND == 0) {
            const float pos = (float)s_idx;
#pragma unroll
            for (int j = 0; j < 8; ++j) { float s, c; sincos_rr(pos * inv[j], s, c); const float a1 = x[j], a2 = x[j + 8]; x[j] = a1 * c - a2 * s; x[j + 8] = a2 * c + a1 * s; }
        }
        if (KIND == 2) {
            float ss = 0.f;
#pragma unroll
            for (int i = 0; i < 64; ++i) ss += x[i] * x[i];
            const float rstd = 1.0f / sqrtf(ss * (1.0f / 64.0f) + EPS);
#pragma unroll
            for (int i = 0; i < 64; ++i) x[i] = x[i] * rstd * g[i];
            const float pr = (float)(s_idx >> 6), pc = (float)(s_idx & 63);
#pragma unroll
            for (int j = 0; j < 16; ++j) {
                float s, c; sincos_rr(pr * inv[j], s, c);
                const float a1 = x[j], a2 = x[j + 16]; x[j] = a1 * c - a2 * s; x[j + 16] = a2 * c + a1 * s;
                sincos_rr(pc * inv[j], s, c);
                const float b1 = x[32 + j], b2 = x[48 + j]; x[32 + j] = b1 * c - b2 * s; x[48 + j] = b2 * c + b1 * s;
            }
        }
        bf16_t* dst = Kt + (((size_t)(b * NKH + hd) * (SEQ / 64) + (s_idx >> 6)) * 64 + (s_idx & 63)) * 64;
#pragma unroll
        for (int i = 0; i < 8; ++i) { u32x4 o; o.x = pk2(x[8 * i], x[8 * i + 1]); o.y = pk2(x[8 * i + 2], x[8 * i + 3]); o.z = pk2(x[8 * i + 4], x[8 * i + 5]); o.w = pk2(x[8 * i + 6], x[8 * i + 7]);
            *(u32x4*)(dst + 8 * i) = o; }
    }
}
__device__ __forceinline__ void phase_vt(int ld, int voff, int VW, int DV, LAS unsigned char* lds) {
    const KP kp = kparams(); const Ids I = ids(); const int tid = I.tid, vcu = I.vcu, G = I.G;
    const bf16_t* __restrict__ raw = (const bf16_t*)(kp->ws + WS_R1); bf16_t* __restrict__ Vt = (bf16_t*)(kp->ws + WS_R3);
    const int ncb = VW / 256, ntiles = (T / 64) * ncb;
    for (int tile = vcu; tile < ntiles; tile += G) {
        const int tm = tile / ncb, cb = tile - tm * ncb;
        const int tok0 = tm * 64, b = tok0 / SEQ, s0 = tok0 - b * SEQ;
        { const int tok = tid >> 3, c8 = tid & 7;
          const bf16_t* src = raw + (size_t)(tok0 + tok) * ld + voff + cb * 256;
#pragma unroll
          for (int i = 0; i < 4; ++i) { const int ch = c8 + 8 * i; const u32x4 v = *(const u32x4*)(src + ch * 8); *(LAS u32x4*)(lds + tok * 528 + ch * 16) = v; } }
        __syncthreads();
        { const int col = tid >> 1, half = tid & 1;
          unsigned w[16];
#pragma unroll
          for (int i = 0; i < 16; ++i) { const unsigned lo = *(const LAS unsigned short*)(lds + (32 * half + 2 * i) * 528 + col * 2);
              const unsigned hi = *(const LAS unsigned short*)(lds + (32 * half + 2 * i + 1) * 528 + col * 2); w[i] = lo | (hi << 16); }
          const int cc = cb * 256 + col, vh = cc / DV, d = cc - vh * DV;
          bf16_t* dst = Vt + ((((size_t)b * (VW / DV) + vh) * (SEQ / 64) + (s0 >> 6)) * DV + d) * 64 + 32 * half;
#pragma unroll
          for (int i = 0; i < 4; ++i) { u32x4 o; o.x = w[4 * i]; o.y = w[4 * i + 1]; o.z = w[4 * i + 2]; o.w = w[4 * i + 3]; *(u32x4*)(dst + 8 * i) = o; } }
        __syncthreads();
    }
}
__device__ __forceinline__ void phase_subln(int layer, int jj) {
    layer = __builtin_amdgcn_readfirstlane(layer); jj = __builtin_amdgcn_readfirstlane(jj); asm volatile("" : "+s"(layer), "+s"(jj));
    const KP kp = kparams(); const Ids I = ids(); const int gw = I.gw, NGW = I.NGW, lane = I.lane;
    const bf16_t* __restrict__ Opart = (const bf16_t*)(kp->ws + WS_R5); bf16_t* __restrict__ xo = (bf16_t*)(kp->ws + WS_R2);
    const float* __restrict__ lamv = kp->diff_lambda + (size_t)jj * 256; const float* __restrict__ subg = kp->diff_subln + (size_t)jj * 128;
    const float lam_init = 0.8f - 0.6f * expf(-0.3f * (float)layer);
    const float d1 = wave_sum(lamv[lane] * lamv[64 + lane]), d2 = wave_sum(lamv[128 + lane] * lamv[192 + lane]);
    const float lam = expf(d1) - expf(d2) + lam_init;
    const float osc = 1.0f - lam_init;
    const int sub = lane & 15;
    float g[8];
#pragma unroll
    for (int i = 0; i < 8; ++i) g[i] = subg[8 * sub + i] * osc;
    for (int it = gw; it < T * 2; it += NGW) {
        const int item = it * 4 + (lane >> 4); const int t = item >> 3, hd = item & 7;
        const bf16_t* src = Opart + (size_t)t * 2048 + hd * 256 + 8 * sub;
        const u32x4 a = *(const u32x4*)src, b = *(const u32x4*)(src + 128);
        float o[8];
        o[0] = bflo(a.x) - lam * bflo(b.x); o[1] = bfhi(a.x) - lam * bfhi(b.x); o[2] = bflo(a.y) - lam * bflo(b.y); o[3] = bfhi(a.y) - lam * bfhi(b.y);
        o[4] = bflo(a.z) - lam * bflo(b.z); o[5] = bfhi(a.z) - lam * bfhi(b.z); o[6] = bflo(a.w) - lam * bflo(b.w); o[7] = bfhi(a.w) - lam * bfhi(b.w);
        float ss = 0.f;
#pragma unroll
        for (int i = 0; i < 8; ++i) ss += o[i] * o[i];
        ss += __shfl_xor(ss, 1); ss += __shfl_xor(ss, 2); ss += __shfl_xor(ss, 4); ss += __shfl_xor(ss, 8);
        const float rstd = 1.0f / sqrtf(ss * (1.0f / 128.0f) + EPS);
        u32x4 w; w.x = pk2(o[0] * rstd * g[0], o[1] * rstd * g[1]); w.y = pk2(o[2] * rstd * g[2], o[3] * rstd * g[3]);
        w.z = pk2(o[4] * rstd * g[4], o[5] * rstd * g[5]); w.w = pk2(o[6] * rstd * g[6], o[7] * rstd * g[7]);
        *(u32x4*)(xo + (size_t)t * DM + hd * 128 + 8 * sub) = w;
    }
}

__device__ __forceinline__ unsigned cvtpk(float lo, float hi) { unsigned r; asm volatile("v_cvt_pk_bf16_f32 %0, %1, %2" : "=v"(r) : "v"(lo), "v"(hi)); return r; }
template <int DV, int MODE>
__device__ __forceinline__ void attn_unit(LAS unsigned char* lds, const bf16_t* __restrict__ Qp, int ldq, const bf16_t* __restrict__ Kp, int ldk,
                                          const bf16_t* __restrict__ Vp, bf16_t* __restrict__ Op, int ldo, int t_lo, int t_hi, const float* __restrict__ rpb_h, int r4, int tid) {
    constexpr int KROW = 144, KB_BYTES = 64 * KROW, VB_BYTES = DV * KROW, BUF = KB_BYTES + VB_BYTES, NDB = DV / 32, NVP = DV / 64;
    constexpr float cscale = 1.0f;
    const int lane = tid & 63, wid = __builtin_amdgcn_readfirstlane(tid >> 6), j = lane & 31, hi = lane >> 5;
    bf16x8 qf[4];
    { const bf16_t* qrow = Qp + (size_t)(wid * 32 + j) * ldq + hi * 8;
#pragma unroll
      for (int d0 = 0; d0 < 4; ++d0) qf[d0] = *(const bf16x8*)(qrow + d0 * 16); }
    const int srow = tid >> 3, sch = tid & 7;
    const bf16_t* kg = Kp + tid * 8;
    const bf16_t* vg = Vp + tid * 8;
    const int ks_off = srow * KROW + sch * 16;
    const int kap = (j & 0x13) | ((j & 4) << 1) | ((j & 8) >> 1);
    const int kr_off = kap * KROW + hi * 16;
    const int vr_off = KB_BYTES + j * KROW + hi * 16;
    LAS float* rp = (LAS float*)(lds + 2 * BUF);
    int qr = 0, qc = 0, r0 = 0, cs = 0;
    if (MODE == 1) {
        qr = r4 + (wid >> 1); qc = (wid & 1) * 32 + j;
        r0 = qr - 4; r0 = r0 < 0 ? 0 : (r0 > 120 ? 120 : r0);
        cs = qc - 8; cs = cs < 0 ? 0 : (cs > 48 ? 48 : cs);
        for (int i = tid; i < 15 * 31; i += 512) rp[i] = rpb_h[i] * LOG2E;
    }
    u32x4 kreg, vreg[NVP];
    kreg = *(const u32x4*)(kg + (size_t)t_lo * 4096);
#pragma unroll
    for (int pt = 0; pt < NVP; ++pt) vreg[pt] = *(const u32x4*)(vg + (size_t)t_lo * (DV * 64) + pt * 4096);
    *(LAS u32x4*)(lds + ks_off) = kreg;
#pragma unroll
    for (int pt = 0; pt < NVP; ++pt) *(LAS u32x4*)(lds + KB_BYTES + pt * 64 * KROW + ks_off) = vreg[pt];
    __syncthreads();
    float m_run = -INFINITY, l_run = 0.f;
    f32x16 o[NDB];
#pragma unroll
    for (int db = 0; db < NDB; ++db)
#pragma unroll
        for (int r = 0; r < 16; ++r) o[db][r] = 0.f;
    for (int t = t_lo; t < t_hi; ++t) {
        const int bufoff = ((t - t_lo) & 1) * BUF;
        const bool more = (t + 1 < t_hi);
        if (more) {
            kreg = *(const u32x4*)(kg + (size_t)(t + 1) * 4096);
#pragma unroll
            for (int pt = 0; pt < NVP; ++pt) vreg[pt] = *(const u32x4*)(vg + (size_t)(t + 1) * (DV * 64) + pt * 4096);
        }
        bool active = true;
        if (MODE == 1) active = (t >= r0) && (t < r0 + 8);
        if (active) {
            f32x16 s0, s1;
#pragma unroll
            for (int r = 0; r < 16; ++r) { s0[r] = 0.f; s1[r] = 0.f; }
#pragma unroll
            for (int d0 = 0; d0 < 4; ++d0) {
                const bf16x8 k0 = *(const LAS bf16x8*)(lds + bufoff + kr_off + d0 * 32);
                const bf16x8 k1 = *(const LAS bf16x8*)(lds + bufoff + kr_off + 32 * KROW + d0 * 32);
                s0 = __builtin_amdgcn_mfma_f32_32x32x16_bf16(k0, qf[d0], s0, 0, 0, 0);
                s1 = __builtin_amdgcn_mfma_f32_32x32x16_bf16(k1, qf[d0], s1, 0, 0, 0);
            }
            if (MODE == 1) {
                const int dr = t - qr + 7;
#pragma unroll
                for (int r = 0; r < 16; ++r) {
                    { const int kc = 16 * (r >> 3) + 8 * hi + (r & 7); const bool ok = (kc >= cs) && (kc < cs + 16);
                      const float bias = rp[ok ? dr * 31 + (kc - qc + 15) : 0]; s0[r] = ok ? __builtin_fmaf(s0[r], cscale, bias) : -INFINITY; }
                    { const int kc = 32 + 16 * (r >> 3) + 8 * hi + (r & 7); const bool ok = (kc >= cs) && (kc < cs + 16);
                      const float bias = rp[ok ? dr * 31 + (kc - qc + 15) : 0]; s1[r] = ok ? __builtin_fmaf(s1[r], cscale, bias) : -INFINITY; }
                }
            }
            constexpr float sc = (MODE == 1) ? 1.0f : cscale;
            float mx = fmaxf(s0[0], s1[0]);
#pragma unroll
            for (int r = 1; r < 16; ++r) mx = fmaxf(mx, fmaxf(s0[r], s1[r]));
            mx = fmaxf(mx, __shfl_xor(mx, 32));
            const float m_new = fmaxf(m_run, mx * sc);
            const float alpha = __builtin_amdgcn_exp2f(m_run - m_new);
            m_run = m_new;
            float ls = 0.f;
#pragma unroll
            for (int r = 0; r < 16; ++r) { s0[r] = __builtin_amdgcn_exp2f(__builtin_fmaf(s0[r], sc, -m_new)); s1[r] = __builtin_amdgcn_exp2f(__builtin_fmaf(s1[r], sc, -m_new)); ls += s0[r] + s1[r]; }
            l_run = l_run * alpha + ls;
#pragma unroll
            for (int db = 0; db < NDB; ++db)
#pragma unroll
                for (int r = 0; r < 16; ++r) o[db][r] *= alpha;
            bf16x8 pf[2][2];
#pragma unroll
            for (int c = 0; c < 2; ++c) {
                u32x4 w0, w1;
                w0.x = cvtpk(s0[8 * c + 0], s0[8 * c + 1]); w0.y = cvtpk(s0[8 * c + 2], s0[8 * c + 3]); w0.z = cvtpk(s0[8 * c + 4], s0[8 * c + 5]); w0.w = cvtpk(s0[8 * c + 6], s0[8 * c + 7]);
                w1.x = cvtpk(s1[8 * c + 0], s1[8 * c + 1]); w1.y = cvtpk(s1[8 * c + 2], s1[8 * c + 3]); w1.z = cvtpk(s1[8 * c + 4], s1[8 * c + 5]); w1.w = cvtpk(s1[8 * c + 6], s1[8 * c + 7]);
                pf[0][c] = __builtin_bit_cast(bf16x8, w0); pf[1][c] = __builtin_bit_cast(bf16x8, w1);
            }
#pragma unroll
            for (int db = 0; db < NDB; ++db)
#pragma unroll
                for (int kb = 0; kb < 2; ++kb)
#pragma unroll
                    for (int c = 0; c < 2; ++c) {
                        const bf16x8 vf = *(const LAS bf16x8*)(lds + bufoff + vr_off + db * 32 * KROW + kb * 64 + c * 32);
                        o[db] = __builtin_amdgcn_mfma_f32_32x32x16_bf16(vf, pf[kb][c], o[db], 0, 0, 0);
                    }
        }
        if (more) {
            const int nb = BUF - bufoff;
            *(LAS u32x4*)(lds + nb + ks_off) = kreg;
#pragma unroll
            for (int pt = 0; pt < NVP; ++pt) *(LAS u32x4*)(lds + nb + KB_BYTES + pt * 64 * KROW + ks_off) = vreg[pt];
        }
        __syncthreads();
    }
    const float l_tot = l_run + __shfl_xor(l_run, 32);
    const float inv = 1.0f / l_tot;
    bf16_t* orow = Op + (size_t)(wid * 32 + j) * ldo + 4 * hi;
#pragma unroll
    for (int db = 0; db < NDB; ++db)
#pragma unroll
        for (int g = 0; g < 4; ++g) {
            u32x2 w; w.x = cvtpk(o[db][4 * g] * inv, o[db][4 * g + 1] * inv); w.y = cvtpk(o[db][4 * g + 2] * inv, o[db][4 * g + 3] * inv);
            *(u32x2*)(orow + 32 * db + 8 * g) = w;
        }
}
#define SB() __builtin_amdgcn_sched_barrier(0)
__device__ __forceinline__ float max3f(float a, float b, float c) { float r; asm("v_max3_f32 %0, %1, %2, %3" : "=v"(r) : "v"(a), "v"(b), "v"(c)); return r; }
__device__ __forceinline__ float xhalf_max(float m) { float a = m, b = m; asm volatile("s_nop 1\n\tv_permlane32_swap_b32 %0, %1\n\ts_nop 1" : "+v"(a), "+v"(b)); return max3f(a, b, b); }
__device__ __forceinline__ float xhalf_sum(float m) { float a = m, b = m; asm volatile("s_nop 1\n\tv_permlane32_swap_b32 %0, %1\n\ts_nop 1" : "+v"(a), "+v"(b)); return a + b; }
template <int DV>
__device__ __forceinline__ void attn_unit_dense(LAS unsigned char* lds, const bf16_t* __restrict__ Qp, int ldq, const bf16_t* __restrict__ Kp, int ldk,
                                                const bf16_t* __restrict__ Vp, bf16_t* __restrict__ Op, int ldo, int tid, int rot) {
    constexpr int KROW = 144, KB_BYTES = 64 * KROW, VB_BYTES = DV * KROW, NDB = DV / 32, NVP = DV / 64, NT = SEQ / 64;
    const int lane = tid & 63, wid = __builtin_amdgcn_readfirstlane(tid >> 6), j = lane & 31, hi = lane >> 5;
    bf16x8 qf[4];
    { const bf16_t* qrow = Qp + (size_t)(wid * 32 + j) * ldq + hi * 8;
#pragma unroll
      for (int d0 = 0; d0 < 4; ++d0) qf[d0] = *(const bf16x8*)(qrow + d0 * 16); }
    const int srow = tid >> 3, sch = tid & 7;
    const bf16_t* kg = Kp + tid * 8;
    const bf16_t* vg = Vp + tid * 8;
    const int ks_off = srow * KROW + sch * 16;
    const int kap = (j & 0x13) | ((j & 4) << 1) | ((j & 8) >> 1);
    const LAS unsigned char* kbase = lds + kap * KROW + hi * 16;
    const LAS unsigned char* vbase = lds + 2 * KB_BYTES + j * KROW + hi * 16;
    LAS unsigned char* kst = lds + ks_off;
    LAS unsigned char* vst = lds + 2 * KB_BYTES + ks_off;
    u32x4 kreg, vreg[NVP];
    kreg = *(const u32x4*)(kg + (size_t)(rot & (NT - 1)) * 4096);
#pragma unroll
    for (int pt = 0; pt < NVP; ++pt) vreg[pt] = *(const u32x4*)(vg + (size_t)(rot & (NT - 1)) * (DV * 64) + pt * 4096);
    *(LAS u32x4*)kst = kreg;
#pragma unroll
    for (int pt = 0; pt < NVP; ++pt) *(LAS u32x4*)(vst + pt * 64 * KROW) = vreg[pt];
    kreg = *(const u32x4*)(kg + (size_t)((rot + 1) & (NT - 1)) * 4096);
    *(LAS u32x4*)(kst + KB_BYTES) = kreg;
    __syncthreads();
    f32x16 S[2][2];
    f32x16 o[NDB];
#pragma unroll
    for (int db = 0; db < NDB; ++db)
#pragma unroll
        for (int r = 0; r < 16; ++r) o[db][r] = 0.f;
#pragma unroll
    for (int r = 0; r < 16; ++r) { S[0][0][r] = 0.f; S[0][1][r] = 0.f; }
#pragma unroll
    for (int d0 = 0; d0 < 4; ++d0) {
        const bf16x8 k0 = *(const LAS bf16x8*)(kbase + d0 * 32);
        const bf16x8 k1 = *(const LAS bf16x8*)(kbase + 32 * KROW + d0 * 32);
        S[0][0] = __builtin_amdgcn_mfma_f32_32x32x16_bf16(k0, qf[d0], S[0][0], 0, 0, 0);
        S[0][1] = __builtin_amdgcn_mfma_f32_32x32x16_bf16(k1, qf[d0], S[0][1], 0, 0, 0);
    }
    __syncthreads();
    float m_ref, l_run = 0.f;
    { float mx = fmaxf(S[0][0][0], S[0][1][0]);
#pragma unroll
      for (int r = 1; r < 16; ++r) mx = max3f(mx, S[0][0][r], S[0][1][r]);
      m_ref = xhalf_max(mx);
#pragma unroll
      for (int r = 0; r < 16; ++r) { S[0][0][r] = __builtin_amdgcn_exp2f(S[0][0][r] - m_ref); S[0][1][r] = __builtin_amdgcn_exp2f(S[0][1][r] - m_ref); } }
    for (int t = 0; t < NT; t += 2) {
#pragma unroll
        for (int u = 0; u < 2; ++u) {
            const int tt = t + u;
            const bool more1 = (tt + 1 < NT), more2 = (tt + 2 < NT);
            if (more2) kreg = *(const u32x4*)(kg + (size_t)((tt + 2 + rot) & (NT - 1)) * 4096);
            if (more1) {
#pragma unroll
                for (int pt = 0; pt < NVP; ++pt) vreg[pt] = *(const u32x4*)(vg + (size_t)((tt + 1 + rot) & (NT - 1)) * (DV * 64) + pt * 4096);
            }
            f32x16 (&Pc)[2] = S[u];
            f32x16 (&Sn)[2] = S[u ^ 1];
            const LAS unsigned char* kb_ = kbase + (u ^ 1) * KB_BYTES;
            const LAS unsigned char* vb_ = vbase + u * VB_BYTES;
            bf16x8 kf[8];
#pragma unroll
            for (int i = 0; i < 2; ++i) kf[i] = *(const LAS bf16x8*)(kb_ + (i & 1) * 32 * KROW + (i >> 1) * 32);
            SB();
            u32x4 pw[2][2];
            float sacc = 0.f;
#pragma unroll
            for (int g = 0; g < 8; ++g) {
                const int d0 = g >> 1, kb = g & 1;
                if (g + 2 < 8) { const int i = g + 2; kf[i] = *(const LAS bf16x8*)(kb_ + (i & 1) * 32 * KROW + (i >> 1) * 32); }
                if (d0 == 0) { f32x16 z;
#pragma unroll
                    for (int r = 0; r < 16; ++r) z[r] = 0.f;
                    Sn[kb] = __builtin_amdgcn_mfma_f32_32x32x16_bf16(kf[g], qf[0], z, 0, 0, 0); }
                else Sn[kb] = __builtin_amdgcn_mfma_f32_32x32x16_bf16(kf[g], qf[d0], Sn[kb], 0, 0, 0);
                { const int pk = g >> 2, r0 = 4 * (g & 3), c = (g & 3) >> 1, w = 2 * (g & 1);
                  sacc += Pc[pk][r0]; sacc += Pc[pk][r0 + 1]; sacc += Pc[pk][r0 + 2]; sacc += Pc[pk][r0 + 3];
                  pw[pk][c][w] = cvtpk(Pc[pk][r0], Pc[pk][r0 + 1]); pw[pk][c][w + 1] = cvtpk(Pc[pk][r0 + 2], Pc[pk][r0 + 3]);
                  asm volatile("" : "+v"(sacc)); }
                SB();
            }
            l_run += sacc;
            float mx = fmaxf(Sn[0][0], Sn[1][0]);
#pragma unroll
            for (int r = 1; r < 16; ++r) mx = max3f(mx, Sn[0][r], Sn[1][r]);
            mx = xhalf_max(mx);
            const float m_new = max3f(m_ref, mx, mx);
            const float fsc = __builtin_amdgcn_exp2f(m_ref - m_new);
            const bool grew = m_new > m_ref;
            m_ref = m_new; l_run *= fsc;
            asm volatile("" : "+v"(m_ref));
            SB();
            constexpr int NG = 4 * NDB;
            constexpr int EPG = 32 / NG;
            bf16x8 vf[NG];
#pragma unroll
            for (int i = 0; i < 2; ++i) vf[i] = *(const LAS bf16x8*)(vb_ + (i % NDB) * 32 * KROW + ((i / NDB) >> 1) * 64 + ((i / NDB) & 1) * 32);
            SB();
#pragma unroll
            for (int g = 0; g < NG; ++g) {
                if (g + 2 < NG) { const int i = g + 2; vf[i] = *(const LAS bf16x8*)(vb_ + (i % NDB) * 32 * KROW + ((i / NDB) >> 1) * 64 + ((i / NDB) & 1) * 32); }
                const int db = g % NDB, kc = g / NDB, kb = kc >> 1, c = kc & 1;
                o[db] = __builtin_amdgcn_mfma_f32_32x32x16_bf16(vf[g], __builtin_bit_cast(bf16x8, pw[kb][c]), o[db], 0, 0, 0);
#pragma unroll
                for (int e = 0; e < EPG; ++e) { const int idx = g * EPG + e, sk = idx >> 4, r = idx & 15;
                    float v = __builtin_amdgcn_exp2f(Sn[sk][r] - m_ref); asm volatile("" : "+v"(v)); Sn[sk][r] = v; }
                SB();
            }
            if (__any(grew)) {
#pragma unroll
                for (int db = 0; db < NDB; ++db)
#pragma unroll
                    for (int r = 0; r < 16; ++r) o[db][r] *= fsc;
            }
            if (more2) *(LAS u32x4*)(kst + u * KB_BYTES) = kreg;
            if (more1) {
#pragma unroll
                for (int pt = 0; pt < NVP; ++pt) *(LAS u32x4*)(vst + (u ^ 1) * VB_BYTES + pt * 64 * KROW) = vreg[pt];
            }
            __syncthreads();
        }
    }
    const float l_tot = xhalf_sum(l_run);
    const float inv = 1.0f / l_tot;
    bf16_t* orow = Op + (size_t)(wid * 32 + j) * ldo + 4 * hi;
#pragma unroll
    for (int db = 0; db < NDB; ++db)
#pragma unroll
        for (int g = 0; g < 4; ++g) {
            u32x2 w; w.x = cvtpk(o[db][4 * g] * inv, o[db][4 * g + 1] * inv); w.y = cvtpk(o[db][4 * g + 2] * inv, o[db][4 * g + 3] * inv);
            *(u32x2*)(orow + 32 * db + 8 * g) = w;
        }
}
template <int KIND>
__device__ __forceinline__ void phase_attn(LAS unsigned char* lds, int jj) {
    constexpr int DV = (KIND == 0) ? 128 : 64, MODE = (KIND == 1) ? 1 : 0;
    constexpr int ldq = (KIND == 2) ? 1536 : 3072, kv_shift = (KIND == 2) ? 2 : 0, vh_shift = (KIND == 0) ? 1 : (KIND == 2 ? 2 : 0), VW = (KIND == 2) ? 256 : 1024, ldo = (KIND == 0) ? 2048 : 1024;
    const KP kp = kparams(); const Ids I = ids();
    const bf16_t* Q = (const bf16_t*)(kp->ws + WS_R1); const bf16_t* Kt = (const bf16_t*)(kp->ws + WS_R2); const bf16_t* Vt = (const bf16_t*)(kp->ws + WS_R3);
    bf16_t* O = (bf16_t*)(kp->ws + WS_R5);
    constexpr int NKH = (KIND == 2) ? 4 : 16, NVH = VW / DV;
    const float* rpb = (KIND == 1) ? kp->na_rpb + (size_t)jj * 16 * 465 : nullptr;
    constexpr int NU = BATCH * 16 * 32;
    for (int u = I.vcu; u < NU; u += I.G) {
        const int bh = u >> 5, qb = u & 31, b = bh >> 4, hd = bh & 15;
        const bf16_t* Qp = Q + (size_t)(b * SEQ + qb * 256) * ldq + hd * 64;
        const bf16_t* Kp = Kt + (size_t)(b * NKH + (hd >> kv_shift)) * (SEQ / 64) * 4096;
        const bf16_t* Vp = Vt + (size_t)(b * NVH + (hd >> vh_shift)) * (SEQ / 64) * (DV * 64);
        bf16_t* Op = O + (size_t)(b * SEQ + qb * 256) * ldo + hd * DV;
        int t_lo = 0, t_hi = SEQ / 64;
        if (MODE == 1) { const int r4 = 4 * qb; t_lo = r4 - 4; t_lo = t_lo < 0 ? 0 : (t_lo > 120 ? 120 : t_lo); int rl = r4 + 3 - 4; rl = rl < 0 ? 0 : (rl > 120 ? 120 : rl); t_hi = rl + 8; }
        if (MODE == 1) attn_unit<DV, MODE>(lds, Qp, ldq, Kp, ldq, Vp, Op, ldo, t_lo, t_hi, rpb + hd * 465, 4 * qb, I.tid);
        else attn_unit_dense<DV>(lds, Qp, ldq, Kp, ldq, Vp, Op, ldo, I.tid, 4 * qb);
    }
}
template <bool SWIGLU>
__device__ __forceinline__ void phase_gemm(LAS unsigned char* lds, int which, int f, int Nin, int kind) {
    const KP kp = kparams(); int b = blockIdx.x; asm volatile("" : "+s"(b)); const int G = gridDim.x;
    unsigned char* ws = kp->ws;
    if (SWIGLU) {
        pg8::Gemm g{(const bf16_t*)(ws + WS_R2), (const bf16_t*)(ws + WS_W + (f ? WO_GU1 : WO_GU0)), T, 2 * DFF, DM}; pg8::StaticOrder S; S.init(T, 2 * DFF, G, b);
        pg8::EpiSwiglu E{(bf16_t*)(ws + WS_R1), DFF};
        pg8::gemm_phase<pg8::EpiSwiglu, pg8::StaticOrder, true, true>(lds, g, S, E);
    } else {
        const bf16_t* A; const bf16_t* Bt; bf16_t* O; int N, K;
        if (which == 1) { A = (const bf16_t*)(ws + WS_R1); Bt = (const bf16_t*)(ws + WS_W + (f ? WO_D1 : WO_D0)); O = (bf16_t*)(ws + WS_R3); N = DM; K = DFF; }
        else if (which == 2) { A = (const bf16_t*)(ws + WS_R2); Bt = (const bf16_t*)(ws + WS_W + WO_IN); O = (bf16_t*)(ws + WS_R1); N = Nin; K = DM; }
        else { A = (const bf16_t*)(ws + (kind == 0 ? WS_R2 : WS_R5)); Bt = (const bf16_t*)(ws + WS_W + WO_OUT); O = (bf16_t*)(ws + WS_R3); N = DM; K = DM; }
        pg8::Gemm g{A, Bt, T, N, K}; pg8::StaticOrder S; S.init(T, N, G, b);
        pg8::EpiStore E{O, N, (which == 2 && Nin == 3072) ? 1024 : 0, 0.125f * LOG2E};
        pg8::gemm_phase<pg8::EpiStore, pg8::StaticOrder, true, true>(lds, g, S, E);
    }
}

__global__ void __launch_bounds__(512, 2) fwd_kernel(Params p_unused) {
    extern __shared__ __attribute__((aligned(16))) unsigned char lds_raw[];
    LAS unsigned char* lds = (LAS unsigned char*)lds_raw;
    cg::grid_group grid = cg::this_grid();

    unsigned* barw = (unsigned*)(kparams()->ws + WS_BAR);
    if (blockIdx.x == 0) for (int i = threadIdx.x; i < XCD_BAR_WORDS; i += 512) barw[i] = 0u;
    if (threadIdx.x < 2) ((volatile LAS unsigned*)(lds + LDS_ST_OFF))[threadIdx.x] = 0u;
    phase_convert(0, lds);
    phase_init_rows();
    grid.sync();
    const XcdBarrier xbar = xcd_barrier_post((unsigned*)(kparams()->ws + WS_BAR), (volatile LAS unsigned*)(lds + LDS_ST_OFF));
#define GRID_SYNC() xcd_barrier(xbar)

    for (int layer = 0; layer < 4; ++layer) {
        const int kind = layer % 3, jj = layer / 3;
        const int Nin = (kind == 2) ? 1536 : 3072;
        for (int sub = 0; sub < 3; ++sub) {
            if (sub != 1) {
                phase_gemm<true>(lds, 0, sub >> 1, 0, 0);
                GRID_SYNC();
            }
            for (int rep = 0; rep < 2; ++rep) {
                if (rep == 1) {
                    if (sub != 1) break;
                    if (kind == 0) {
                        phase_post_a();
                        phase_kpack<0>(jj);
                        phase_vt(3072, 2048, 1024, 128, lds);
                        GRID_SYNC();
                        phase_attn<0>(lds, jj);
                        GRID_SYNC();
                        phase_subln(layer, jj);
                    } else if (kind == 1) {
                        phase_kpack<1>(jj);
                        phase_vt(3072, 2048, 1024, 64, lds);
                        GRID_SYNC();
                        phase_attn<1>(lds, jj);
                    } else {
                        phase_post_c(jj);
                        phase_kpack<2>(jj);
                        phase_vt(1536, 1280, 256, 64, lds);
                        GRID_SYNC();
                        phase_attn<2>(lds, jj);
                    }
                    GRID_SYNC();
                }
                phase_gemm<false>(lds, rep == 1 ? 3 : (sub == 1 ? 2 : 1), sub >> 1, Nin, kind);
                GRID_SYNC();
            }
            phase_rowwise(layer, sub);
            if (sub == 2 && layer < 3) phase_convert(layer + 1, lds);
            GRID_SYNC();
        }
    }
}

extern "C" void kernel_launch(void* const* d_in, const int* in_sizes, int n_in, void* d_out, int out_size, void* d_ws, size_t ws_size, hipStream_t stream) {
    static int grid_blocks = 0;
    if (grid_blocks == 0) {
        if (n_in != 18 || in_sizes[0] != T * DM || out_size != T * DM || ws_size < WS_NEED) {
            fprintf(stderr, "kernel_launch: unexpected shapes: n_in %d in0 %d out %d ws %zu (need %zu)\n", n_in, n_in > 0 ? in_sizes[0] : -1, out_size, ws_size, (size_t)WS_NEED);
            grid_blocks = -1; return; }
        int dev = 0, cus = 0, per_cu = 0;
        hipGetDevice(&dev);
        hipDeviceGetAttribute(&cus, hipDeviceAttributeMultiprocessorCount, dev);
        if (hipFuncSetAttribute((const void*)fwd_kernel, hipFuncAttributeMaxDynamicSharedMemorySize, LDS_BYTES) != hipSuccess) { fprintf(stderr, "kernel_launch: hipFuncSetAttribute failed\n"); grid_blocks = -1; return; }
        if (hipOccupancyMaxActiveBlocksPerMultiprocessor(&per_cu, (const void*)fwd_kernel, 512, LDS_BYTES) != hipSuccess || per_cu < 1) { fprintf(stderr, "kernel_launch: occupancy query failed (%d)\n", per_cu); per_cu = 1; }
        (void)hipGetLastError();
        grid_blocks = cus * per_cu;
    }
    if (grid_blocks < 0) return;
    Params p{};
    p.x = (const float*)d_in[0]; p.norm_g = (const float*)d_in[1];
    p.ffn_wg[0] = (const float*)d_in[2]; p.ffn_wu[0] = (const float*)d_in[3]; p.ffn_wd[0] = (const float*)d_in[4];
    p.ffn_wg[1] = (const float*)d_in[5]; p.ffn_wu[1] = (const float*)d_in[6]; p.ffn_wd[1] = (const float*)d_in[7];
    p.diff_w_in = (const float*)d_in[8]; p.diff_w_out = (const float*)d_in[9]; p.diff_lambda = (const float*)d_in[10]; p.diff_subln = (const float*)d_in[11];
    p.na_w_in = (const float*)d_in[12]; p.na_w_out = (const float*)d_in[13]; p.na_rpb = (const float*)d_in[14];
    p.gqa_w_in = (const float*)d_in[15]; p.gqa_w_out = (const float*)d_in[16]; p.gqa_qk_norm = (const float*)d_in[17];
    p.out = (float*)d_out; p.ws = (unsigned char*)d_ws;
    for (int j = 0; j < 8; ++j) p.inv_a[j] = (float)pow(500000.0, -(double)(2 * j) / 16.0);
    for (int j = 0; j < 16; ++j) p.inv_c[j] = (float)pow(10000.0, -(double)(2 * j) / 32.0);
    void* args[] = {&p};
    hipError_t e = hipLaunchCooperativeKernel((const void*)fwd_kernel, dim3(grid_blocks), dim3(512), args, LDS_BYTES, stream);
    if (e != hipSuccess) fprintf(stderr, "kernel_launch: cooperative launch failed: %s (grid %d)\n", hipGetErrorString(e), grid_blocks);
}
```
